# Optimizing an MI355X kernel written in HIP

```python
import math
import jax, jax.numpy as jnp
from jax import lax
import numpy as np

D_MODEL = 1024
BATCH = 8
SEQ = 2048
DEPTH = 2

GRID_W = 64
CTX_LEN = 256
N_MIXERS = 2
N_HYENA = (DEPTH + 1) // 2
N_RGLRU = DEPTH // 2
D_FF = 2816
N_MOD = 9
MACARON = 0.5
NORM_EPS = 1e-6
POS_BASE = 10000.0
HY_WIDTH = D_MODEL
HY_SHORT = 3
HY_EMB = 33
HY_BANDS = (HY_EMB - 1) // 2
HY_FILTER_HIDDEN = 64
HY_FAST_DECAY = 0.3
HY_SLOW_DECAY = 1.5
HY_DECAY_TARGET = 1e-2
RG_WIDTH = D_MODEL
RG_HEADS = 4
RG_BLOCK = RG_WIDTH // RG_HEADS
RG_CONV = 4
RG_C = 8.0

kernel_name = "hybrid_hyena_rglru_prefix_dit"

F32 = jnp.float32


def rmsnorm(x, g):
    xf = x.astype(F32)
    y = xf * lax.rsqrt(jnp.mean(xf * xf, axis=-1, keepdims=True) + NORM_EPS)
    return (y * g.astype(F32)).astype(x.dtype)


def modulate(x, shift, scale):
    return x * (1 + scale) + shift


def dwconv(u, w, b):
    K = w.shape[0]
    L = u.shape[1]
    lo = (K - 1) // 2
    hi = K - 1 - lo
    up = jnp.pad(u, ((0, 0), (lo, hi), (0, 0)))
    out = b
    for k in range(K):
        out = out + up[:, k:k + L] * w[k]
    return out


def grid_pos_embed(L):
    rows = L // GRID_W
    row = jnp.repeat(jnp.arange(rows, dtype=F32), GRID_W)
    col = jnp.tile(jnp.arange(GRID_W, dtype=F32), rows)
    quarter = D_MODEL // 4
    omega = POS_BASE ** (-jnp.arange(quarter, dtype=F32) / quarter)
    def emb(p):
        ang = p[:, None] * omega[None]
        return jnp.concatenate([jnp.sin(ang), jnp.cos(ang)], axis=-1)
    return jnp.concatenate([emb(row), emb(col)], axis=-1)


def ffn_sublayer(x, shift, scale, gate, g_pre, g_post, w1, w3, w2):
    h = modulate(rmsnorm(x, g_pre), shift, scale)
    y = (jax.nn.silu(h @ w1) * (h @ w3)) @ w2
    return x + MACARON * gate * rmsnorm(y, g_post)


def hyena_filters(L, fw0, fb0, fw1, fb1, fw2, fb2, freq, fwout):
    t = jnp.linspace(0.0, 1.0, L, dtype=F32)[:, None]
    w = 2.0 * math.pi * jnp.arange(L, dtype=F32)[:, None] / L
    f = jnp.linspace(1e-4, HY_BANDS - 1, HY_BANDS, dtype=F32)[None]
    phase = f * w
    z = jnp.concatenate([t, jnp.cos(phase), -jnp.sin(phase)], axis=-1)
    hdn = jnp.sin(freq[0] * (z @ fw0 + fb0))
    hdn = jnp.sin(freq[1] * (hdn @ fw1 + fb1))
    hdn = jnp.sin(freq[2] * (hdn @ fw2 + fb2))
    filt = (hdn @ fwout).astype(F32)
    max_decay = math.log(HY_DECAY_TARGET) / HY_FAST_DECAY
    min_decay = math.log(HY_DECAY_TARGET) / HY_SLOW_DECAY
    deltas = jnp.abs(jnp.linspace(min_decay, max_decay, HY_WIDTH, dtype=F32))
    decay = jnp.exp(-t * deltas[None])
    return filt[:, :HY_WIDTH] * decay, filt[:, HY_WIDTH:] * decay


def bidir_long_conv(u, h_fwd, h_bwd, bias):
    L = u.shape[1]
    filt_circ = jnp.concatenate([h_fwd, jnp.zeros_like(h_fwd[:1]), h_bwd[:0:-1]], axis=0)
    k_f = jnp.fft.rfft(filt_circ, n=2 * L, axis=0)
    uf = u.astype(F32)
    u_f = jnp.fft.rfft(uf, n=2 * L, axis=1)
    y = jnp.fft.irfft(u_f * k_f[None], n=2 * L, axis=1)[:, :L]
    return (y + uf * bias.astype(F32)).astype(u.dtype)


def hyena_mixer(h, w_in, b_in, conv_w, conv_b, fw0, fb0, fw1, fb1, fw2, fb2, freq, fwout,
                filt_bias, w_out, b_out):
    L = h.shape[1]
    u = dwconv(h @ w_in + b_in, conv_w, conv_b)
    x0, x1, v = jnp.split(u, 3, axis=-1)
    h_fwd, h_bwd = hyena_filters(L, fw0, fb0, fw1, fb1, fw2, fb2, freq, fwout)
    y = x0 * bidir_long_conv(x1 * v, h_fwd, h_bwd, filt_bias)
    return y @ w_out + b_out


def rglru_coeffs(xc, wa, ba, wi, bi, lam):
    B, L, R = xc.shape
    xh = xc.reshape(B, L, RG_HEADS, RG_BLOCK)
    r = jax.nn.sigmoid((jnp.einsum('blhi,hij->blhj', xh, wa).reshape(B, L, R) + ba).astype(F32))
    i = jax.nn.sigmoid((jnp.einsum('blhi,hij->blhj', xh, wi).reshape(B, L, R) + bi).astype(F32))
    log_a = -RG_C * r * jax.nn.softplus(-lam.astype(F32))
    a = jnp.exp(log_a)
    b = jnp.sqrt(-jnp.expm1(2.0 * log_a)) * i * xc.astype(F32)
    return a, b


def linear_scan(a, b, h0, reverse):
    if h0 is not None:
        first = -1 if reverse else 0
        b = b.at[:, first].add(a[:, first] * h0)
    def combine(left, right):
        a_l, b_l = left
        a_r, b_r = right
        return a_r * a_l, a_r * b_l + b_r
    _, hs = lax.associative_scan(combine, (a, b), axis=1, reverse=reverse)
    return hs


def rglru_mixer(h_c, h_l, ctx_out, w_in, b_in, conv_w, conv_b, wa, ba, wi, bi, lam, w_out, b_out):
    def project(h):
        u = h @ w_in + b_in
        gate_br, rec_br = jnp.split(u, 2, axis=-1)
        return gate_br, dwconv(rec_br, conv_w, conv_b)
    g_c, xc_c = project(h_c)
    g_l, xc_l = project(h_l)
    y_l = 0.0
    y_c = 0.0
    for d, rev in enumerate((False, True)):
        a_c, b_c = rglru_coeffs(xc_c, wa[d], ba[d], wi[d], bi[d], lam[d])
        hs_c = linear_scan(a_c, b_c, None, rev)
        h_end = hs_c[:, 0] if rev else hs_c[:, -1]
        a_l, b_l = rglru_coeffs(xc_l, wa[d], ba[d], wi[d], bi[d], lam[d])
        y_l = y_l + linear_scan(a_l, b_l, h_end, rev)
        if ctx_out:
            y_c = y_c + hs_c
    out_l = ((y_l * jax.nn.gelu(g_l)) @ w_out + b_out).astype(h_l.dtype)
    out_c = ((y_c * jax.nn.gelu(g_c)) @ w_out + b_out).astype(h_c.dtype) if ctx_out else None
    return out_l, out_c


def setup_inputs(seed: int = 0) -> dict:
    key = jax.random.key(seed)
    ks = iter(jax.random.split(key, 64))
    def nrm(shape, scale):
        return jax.random.normal(next(ks), shape, F32) * scale
    D, F, R = D_MODEL, D_FF, RG_WIDTH
    H3 = 3 * HY_WIDTH
    FO = HY_FILTER_HIDDEN
    a_init = jax.random.uniform(next(ks), (N_RGLRU, 2, R), F32, 0.9, 0.999) ** (1.0 / RG_C)
    return {
        "x": nrm((BATCH, SEQ, D), 1.0),
        "c": nrm((BATCH, D), 1.0),
        "ctx": nrm((BATCH, CTX_LEN, D), 1.0),
        "c_ctx": nrm((D,), 1.0),
        "ada_w": nrm((DEPTH, D, N_MOD * D), D ** -0.5),
        "ada_b": nrm((DEPTH, N_MOD * D), 0.01),
        "norm_g": 1.0 + nrm((DEPTH, 6, D), 0.05),
        "ffn_w1": nrm((DEPTH, 2, D, F), D ** -0.5),
        "ffn_w3": nrm((DEPTH, 2, D, F), D ** -0.5),
        "ffn_w2": nrm((DEPTH, 2, F, D), F ** -0.5),
        "hy_w_in": nrm((N_HYENA, D, H3), D ** -0.5),
        "hy_b_in": nrm((N_HYENA, H3), 0.01),
        "hy_conv_w": nrm((N_HYENA, HY_SHORT, H3), HY_SHORT ** -0.5),
        "hy_conv_b": nrm((N_HYENA, H3), 0.01),
        "hy_fw0": nrm((N_HYENA, HY_EMB, FO), HY_EMB ** -0.5),
        "hy_fb0": nrm((N_HYENA, FO), 0.1),
        "hy_fw1": nrm((N_HYENA, FO, FO), FO ** -0.5),
        "hy_fb1": nrm((N_HYENA, FO), 0.1),
        "hy_fw2": nrm((N_HYENA, FO, FO), FO ** -0.5),
        "hy_fb2": nrm((N_HYENA, FO), 0.1),
        "hy_freq": 1.0 + nrm((N_HYENA, 3, FO), 0.05),
        "hy_fwout": nrm((N_HYENA, FO, 2 * HY_WIDTH), FO ** -0.5),
        "hy_filt_bias": nrm((N_HYENA, HY_WIDTH), 1.0),
        "hy_w_out": nrm((N_HYENA, HY_WIDTH, D), HY_WIDTH ** -0.5),
        "hy_b_out": nrm((N_HYENA, D), 0.01),
        "rg_w_in": nrm((N_RGLRU, D, 2 * R), D ** -0.5),
        "rg_b_in": nrm((N_RGLRU, 2 * R), 0.01),
        "rg_conv_w": nrm((N_RGLRU, RG_CONV, R), RG_CONV ** -0.5),
        "rg_conv_b": nrm((N_RGLRU, R), 0.01),
        "rg_wa": nrm((N_RGLRU, 2, RG_HEADS, RG_BLOCK, RG_BLOCK), RG_BLOCK ** -0.5),
        "rg_ba": nrm((N_RGLRU, 2, R), 0.01),
        "rg_wi": nrm((N_RGLRU, 2, RG_HEADS, RG_BLOCK, RG_BLOCK), RG_BLOCK ** -0.5),
        "rg_bi": nrm((N_RGLRU, 2, R), 0.01),
        "rg_lam": jnp.log(a_init) - jnp.log1p(-a_init),
        "rg_w_out": nrm((N_RGLRU, R, D), R ** -0.5),
        "rg_b_out": nrm((N_RGLRU, D), 0.01),
    }


def reference(x, c, ctx, c_ctx, ada_w, ada_b, norm_g, ffn_w1, ffn_w3, ffn_w2,
              hy_w_in, hy_b_in, hy_conv_w, hy_conv_b, hy_fw0, hy_fb0, hy_fw1, hy_fb1,
              hy_fw2, hy_fb2, hy_freq, hy_fwout, hy_filt_bias, hy_w_out, hy_b_out,
              rg_w_in, rg_b_in, rg_conv_w, rg_conv_b, rg_wa, rg_ba, rg_wi, rg_bi, rg_lam,
              rg_w_out, rg_b_out):
    L = x.shape[1]
    x = x + grid_pos_embed(L).astype(x.dtype)[None]
    s = ctx
    for i in range(DEPTH):
        kind = i % N_MIXERS
        j = i // N_MIXERS
        last = i == DEPTH - 1
        ctx_out = not last
        ctx_in = ctx_out or kind == 1
        g = norm_g[i]
        mod_l = jnp.split((jax.nn.silu(c) @ ada_w[i] + ada_b[i])[:, None, :], N_MOD, axis=-1)
        x = ffn_sublayer(x, mod_l[0], mod_l[1], mod_l[2], g[0], g[1],
                         ffn_w1[i, 0], ffn_w3[i, 0], ffn_w2[i, 0])
        if ctx_in:
            mod_c = jnp.split(jax.nn.silu(c_ctx) @ ada_w[i] + ada_b[i], N_MOD, axis=-1)
            s = ffn_sublayer(s, mod_c[0], mod_c[1], mod_c[2], g[0], g[1],
                             ffn_w1[i, 0], ffn_w3[i, 0], ffn_w2[i, 0])
            h_c = modulate(rmsnorm(s, g[2]), mod_c[3], mod_c[4])
        h_l = modulate(rmsnorm(x, g[2]), mod_l[3], mod_l[4])
        if kind == 0:
            hp = (hy_w_in[j], hy_b_in[j], hy_conv_w[j], hy_conv_b[j], hy_fw0[j], hy_fb0[j],
                  hy_fw1[j], hy_fb1[j], hy_fw2[j], hy_fb2[j], hy_freq[j], hy_fwout[j],
                  hy_filt_bias[j], hy_w_out[j], hy_b_out[j])
            y_l = hyena_mixer(h_l, *hp)
            y_c = hyena_mixer(h_c, *hp) if ctx_out else None
        else:
            y_l, y_c = rglru_mixer(h_c, h_l, ctx_out, rg_w_in[j], rg_b_in[j], rg_conv_w[j],
                                   rg_conv_b[j], rg_wa[j], rg_ba[j], rg_wi[j], rg_bi[j],
                                   rg_lam[j], rg_w_out[j], rg_b_out[j])
        x = x + mod_l[5] * rmsnorm(y_l, g[3])
        x = ffn_sublayer(x, mod_l[6], mod_l[7], mod_l[8], g[4], g[5],
                         ffn_w1[i, 1], ffn_w3[i, 1], ffn_w2[i, 1])
        if ctx_out:
            s = s + mod_c[5] * rmsnorm(y_c, g[3])
            s = ffn_sublayer(s, mod_c[6], mod_c[7], mod_c[8], g[4], g[5],
                             ffn_w1[i, 1], ffn_w3[i, 1], ffn_w2[i, 1])
    return x
```

```cpp
#include <hip/hip_runtime.h>
#include <hip/hip_cooperative_groups.h>
#include <cstdio>
#include <cstdint>
namespace cg = cooperative_groups;

#define LAS __attribute__((address_space(3)))
typedef unsigned short bf16_t;
typedef short bf16x8 __attribute__((ext_vector_type(8)));
typedef float f32x4 __attribute__((ext_vector_type(4)));
typedef float f32x2 __attribute__((ext_vector_type(2)));
typedef unsigned u32x4 __attribute__((ext_vector_type(4)));
typedef unsigned u32x2 __attribute__((ext_vector_type(2)));

constexpr int T_ALL = 18432, T_LAT = 16384, DM = 1024, FF = 2816, SEQ = 2048, CTXL = 256, NB = 8;
constexpr int LDS_MAIN = 131072;
constexpr int LDS_BYTES = LDS_MAIN + 16;
constexpr int NPHASE = 26;
#define REPEAT_MASK 0u
constexpr size_t OFF_XS = 0;
constexpr size_t OFF_Y = OFF_XS + 8388608;
constexpr size_t OFF_H = OFF_Y + 37748736;
constexpr size_t OFF_BIG = OFF_H + 37748736;
constexpr size_t OFF_W = OFF_BIG + 113246208;
constexpr size_t OFF_MOD = OFF_W + 42991616;
constexpr size_t OFF_EXTRA = OFF_MOD + 663552;
constexpr size_t OFF_SP8 = OFF_EXTRA + 75497472;
constexpr size_t OFF_BAR = OFF_SP8 + 8192;
constexpr size_t WS_END = OFF_BAR + 16384;
constexpr size_t W_13_0 = 0, W_2_0 = 5767168, W_13_1 = 8650752, W_2_1 = 14417920, W_MIX = 17301504;
constexpr size_t W_HYIN = W_MIX, W_HYOUT = W_MIX + 3145728;
constexpr size_t W_RGIN = W_MIX, W_GATE = W_MIX + 2097152, W_RGOUT = W_MIX + 3145728;
constexpr size_t OFF_FILT = OFF_EXTRA;
constexpr size_t OFF_FILTC = OFF_EXTRA + 8388608;
constexpr size_t OFF_YP = OFF_EXTRA + 16777216;

#define PARG const __attribute__((address_space(4))) Params&
struct Params { const float* in[36]; float* out; unsigned char* ws; int ph_lo, ph_hi; };

__device__ __forceinline__ float bf2f(unsigned v) { return __uint_as_float(v << 16); }
__device__ __forceinline__ unsigned f2bf(float f) { unsigned u = __float_as_uint(f); u += 0x7FFFu + ((u >> 16) & 1u); return u >> 16; }
__device__ __forceinline__ unsigned pack2(float lo, float hi) { return f2bf(lo) | (f2bf(hi) << 16); }
__device__ __forceinline__ unsigned cvt_pk_bf16(float lo, float hi) { unsigned r; asm volatile("v_cvt_pk_bf16_f32 %0, %1, %2" : "=v"(r) : "v"(lo), "v"(hi)); return r; }
__device__ __forceinline__ float sigmoidf_(float x) { return 1.0f / (1.0f + __expf(-x)); }
__device__ __forceinline__ float siluf_(float x) { return x / (1.0f + __expf(-x)); }
__device__ __forceinline__ float geluf_(float x) { const float u = 0.7978845608f * (x + 0.044715f * x * x * x); const float e = __expf(2.0f * u); const float t = 1.0f - 2.0f / (e + 1.0f); return 0.5f * x * (1.0f + t); }
__device__ __forceinline__ float wave_sum(float v) {
#pragma unroll
    for (int o = 32; o > 0; o >>= 1) v += __shfl_xor(v, o, 64);
    return v;
}

namespace pg8 {
constexpr int BM = 256, BK = 64, HALF = 128, HTB = HALF * BK * 2, NXCD = 8, WGM = 8;
__host__ __device__ __forceinline__ int lds_byte(int r, int c) { const int st = (r >> 4) * 2 + (c >> 5), rr = r & 15, cc = c & 31, ob = rr * 64 + cc * 2; return st * 1024 + (ob ^ (((ob >> 9) & 1) << 5)); }
__host__ __device__ __forceinline__ void stage_rc(int b, int& R, int& C) { const int st = b / 1024, sb = b % 1024, swz = sb ^ (((sb >> 9) & 1) << 5); R = (st >> 1) * 16 + swz / 64; C = (st & 1) * 32 + (swz % 64) / 2; }
__host__ __device__ __forceinline__ int perm32(int rho) { const int n = rho >> 4, i = rho & 15; return 8 * (i >> 2) + 4 * n + (i & 3); }
struct Unit { int pm, pn, ks, nt, koff; };
struct Gemm { const bf16_t* A; const bf16_t* Bt; int M, N, K, lda, ldb, agrp, agoff; };
struct StaticOrder {
    int nM, nN, nwg, G, c, nctx, KS, ntt;
    __device__ void init(int M_main, int N, int K, int G_, int c_, int ctx_panels, int ks_) { nM = M_main / BM; nN = N / BM; nwg = nM * nN; G = G_; c = c_; nctx = ctx_panels; KS = ks_; ntt = K / BK; }
    __device__ bool next(int i, Unit& u) const {
        const long L = (long)i * G + c;
        if (L >= nwg) {
            int e = (int)(L - nwg); if (e >= nctx * nN * KS) return false;
            u.ks = e % KS; e /= KS; u.pn = e % nN; u.pm = 64 + e / nN; u.nt = ntt / KS; u.koff = u.ks * u.nt * BK; return true;
        }
        int wgid = (int)L; { const int q = nwg / NXCD, r = nwg % NXCD, xcd = wgid % NXCD, off = wgid / NXCD; wgid = (xcd < r ? xcd * (q + 1) : r * (q + 1) + (xcd - r) * q) + off; }
        const int nig = WGM * nN, gid = wgid / nig, fm = gid * WGM, gsz = (nM - fm) < WGM ? (nM - fm) : WGM;
        u.pm = fm + ((wgid % nig) % gsz); u.pn = (wgid % nig) / gsz; u.ks = 0; u.nt = ntt; u.koff = 0; return true;
    }
};

template <class Epi>
__device__ __forceinline__ void gemm_phase(LAS unsigned char* lds, const Gemm g, const StaticOrder& S, const Epi& E) {
    const int tid = threadIdx.x, wid = __builtin_amdgcn_readfirstlane(tid >> 6), lane = tid & 63, wr = wid >> 2, wc = wid & 3, fr = lane & 15, fq = lane >> 4;
    unsigned voffA[2], voffB[2];
#pragma unroll
    for (int i = 0; i < 2; ++i) { int R, C; stage_rc(tid * 16 + i * 8192, R, C); const int Rb = Epi::PERM ? ((R & ~31) + perm32(R & 31)) : R;
        voffA[i] = (unsigned)(R * g.lda + C) * 2u; voffB[i] = (unsigned)(Rb * g.ldb + C) * 2u; }
    const size_t kstep = (size_t)(BK * 2);
    const size_t hstepA = (size_t)HALF * g.lda * 2, hstepB = (size_t)HALF * g.ldb * 2;
    const size_t tstepA = 2 * hstepA, tstepB = 2 * hstepB;
    const unsigned ldsw = (unsigned)wid * 1024u;
    const int aoff = lds_byte(wr * 64 + fr, fq * 8), boff = lds_byte(wc * 32 + fr, fq * 8);
#define PG8_SA(b, h) (((b) * 2 + (h)) * HTB)
#define PG8_SB(b, h) ((4 + (b) * 2 + (h)) * HTB)
#define PG8_STAGE(bufoff, gbase, voff) do { _Pragma("unroll") for (int _i = 0; _i < 2; ++_i) \
        __builtin_amdgcn_global_load_lds((const unsigned*)((const char*)(gbase) + (voff)[_i]), (LAS unsigned*)(lds + (bufoff) + ldsw + _i * 8192), 16, 0, 0); } while (0)
#define PG8_LDA(dst, b, h) do { _Pragma("unroll") for (int m = 0; m < 4; ++m) _Pragma("unroll") for (int k = 0; k < 2; ++k) dst[m][k] = *(const LAS bf16x8*)(lds + PG8_SA(b, h) + aoff + m * 2048 + k * 1024); } while (0)
#define PG8_LDB(dst, b, h) do { _Pragma("unroll") for (int n = 0; n < 2; ++n) _Pragma("unroll") for (int k = 0; k < 2; ++k) dst[n][k] = *(const LAS bf16x8*)(lds + PG8_SB(b, h) + boff + n * 2048 + k * 1024); } while (0)
#define PG8_MMA(ai, bj, At, Bt) do { __builtin_amdgcn_s_setprio(1); _Pragma("unroll") for (int m = 0; m < 4; ++m) _Pragma("unroll") for (int n = 0; n < 2; ++n) _Pragma("unroll") for (int k = 0; k < 2; ++k) \
        acc[ai][bj][m][n] = __builtin_amdgcn_mfma_f32_16x16x32_bf16(Bt[n][k], At[m][k], acc[ai][bj][m][n], 0, 0, 0); __builtin_amdgcn_s_setprio(0); } while (0)
#define PG8_WAIT_V(n) asm volatile("s_waitcnt vmcnt(" #n ")" ::: "memory")
#define PG8_WAIT_L(n) asm volatile("s_waitcnt lgkmcnt(" #n ")" ::: "memory")
#define PG8_BAR __builtin_amdgcn_s_barrier()
#define PG8_SCHED __builtin_amdgcn_sched_barrier(0)
#define PG8_UA(u) ((const char*)g.A + (size_t)(u).pm * tstepA + (size_t)((u).pn / g.agrp) * (size_t)g.agoff * 2 + (size_t)(u).koff * 2)
#define PG8_UB(u) ((const char*)g.Bt + (size_t)(u).pn * tstepB + (size_t)(u).koff * 2)
    Unit cur, nxt; int ui = 0;
    if (!S.next(0, cur)) return;
    f32x4 acc[2][2][4][2];
#pragma unroll
    for (int a = 0; a < 2; ++a)
#pragma unroll
        for (int b = 0; b < 2; ++b)
#pragma unroll
            for (int m = 0; m < 4; ++m)
#pragma unroll
                for (int n = 0; n < 2; ++n) acc[a][b][m][n] = (f32x4){0.f, 0.f, 0.f, 0.f};
    bf16x8 At[4][2], B0[2][2], B1[2][2];
    const char* cA = PG8_UA(cur); const char* cB = PG8_UB(cur);
    PG8_STAGE(PG8_SB(0, 0), cB, voffB); PG8_STAGE(PG8_SA(0, 0), cA, voffA); PG8_STAGE(PG8_SB(0, 1), cB + hstepB, voffB); PG8_STAGE(PG8_SA(0, 1), cA + hstepA, voffA);
    if (wr == 1) PG8_BAR;
    PG8_WAIT_V(4); PG8_BAR;
    PG8_STAGE(PG8_SB(1, 0), cB + kstep, voffB); PG8_STAGE(PG8_SA(1, 0), cA + kstep, voffA); PG8_STAGE(PG8_SB(1, 1), cB + hstepB + kstep, voffB);
    PG8_WAIT_V(6); PG8_BAR;
    for (;;) {
        const bool has_next = S.next(ui + 1, nxt);
        const char* nA = has_next ? PG8_UA(nxt) : cA; const char* nB = has_next ? PG8_UB(nxt) : cB;
        const int nt = cur.nt;
        for (int t = 0; t < nt; t += 2) {
            const bool last = (t == nt - 2);
            const char* a1 = cA + (size_t)(t + 1) * kstep;
            const char* a2 = last ? nA : cA + (size_t)(t + 2) * kstep; const char* b2 = last ? nB : cB + (size_t)(t + 2) * kstep;
            const char* a3 = a2 + kstep; const char* b3 = b2 + kstep;
            PG8_LDB(B0, 0, 0); PG8_SCHED; PG8_LDA(At, 0, 0); PG8_STAGE(PG8_SA(1, 1), a1 + hstepA, voffA);
            PG8_WAIT_L(8); PG8_BAR; PG8_WAIT_L(0); PG8_MMA(0, 0, At, B0); PG8_BAR; PG8_SCHED;
            PG8_LDB(B1, 0, 1); PG8_STAGE(PG8_SB(0, 0), b2, voffB);
            PG8_BAR; PG8_WAIT_L(0); PG8_MMA(0, 1, At, B1); PG8_BAR;
            PG8_LDA(At, 0, 1); PG8_STAGE(PG8_SA(0, 0), a2, voffA);
            PG8_BAR; PG8_WAIT_L(0); PG8_MMA(1, 0, At, B0); PG8_BAR; PG8_SCHED;
            PG8_STAGE(PG8_SB(0, 1), b2 + hstepB, voffB);
            PG8_WAIT_V(6); PG8_BAR; PG8_MMA(1, 1, At, B1); PG8_BAR;
            PG8_LDB(B0, 1, 0); PG8_SCHED; PG8_LDA(At, 1, 0); PG8_STAGE(PG8_SA(0, 1), a2 + hstepA, voffA);
            PG8_WAIT_L(8); PG8_BAR; PG8_WAIT_L(0); PG8_MMA(0, 0, At, B0); PG8_BAR; PG8_SCHED;
            PG8_LDB(B1, 1, 1); PG8_STAGE(PG8_SB(1, 0), b3, voffB);
            PG8_BAR; PG8_WAIT_L(0); PG8_MMA(0, 1, At, B1); PG8_BAR;
            PG8_LDA(At, 1, 1); PG8_STAGE(PG8_SA(1, 0), a3, voffA);
            PG8_BAR; PG8_WAIT_L(0); PG8_MMA(1, 0, At, B0); PG8_BAR; PG8_SCHED;
            PG8_STAGE(PG8_SB(1, 1), b3 + hstepB, voffB);
            PG8_WAIT_V(6); PG8_BAR; PG8_MMA(1, 1, At, B1); PG8_BAR;
        }
        E(acc, cur, wr, wc, fr, fq);
        if (!has_next) break;
#pragma unroll
        for (int a = 0; a < 2; ++a)
#pragma unroll
            for (int b = 0; b < 2; ++b)
#pragma unroll
                for (int m = 0; m < 4; ++m)
#pragma unroll
                    for (int n = 0; n < 2; ++n) acc[a][b][m][n] = (f32x4){0.f, 0.f, 0.f, 0.f};
        cur = nxt; cA = nA; cB = nB; ++ui;
    }
    PG8_WAIT_V(0);
    if (wr == 0) PG8_BAR;
    PG8_BAR;
#undef PG8_SA
#undef PG8_SB
#undef PG8_STAGE
#undef PG8_LDA
#undef PG8_LDB
#undef PG8_MMA
#undef PG8_WAIT_V
#undef PG8_WAIT_L
#undef PG8_BAR
#undef PG8_SCHED
#undef PG8_UA
#undef PG8_UB
}

struct EpiSwiglu {
    static constexpr bool PERM = true;
    bf16_t* O;
    __device__ __forceinline__ void operator()(const f32x4 (&acc)[2][2][4][2], const Unit& u, int wr, int wc, int fr, int fq) const {
        const int row0 = u.pm * BM + wr * 64 + fr, col0 = u.pn * 128 + wc * 32 + 8 * fq;
#pragma unroll
        for (int ai = 0; ai < 2; ++ai)
#pragma unroll
            for (int m = 0; m < 4; ++m) {
                bf16_t* rowp = O + (size_t)(row0 + ai * HALF + m * 16) * FF + col0;
                float v[8];
#pragma unroll
                for (int n = 0; n < 2; ++n)
#pragma unroll
                    for (int j = 0; j < 4; ++j) v[n * 4 + j] = siluf_(acc[ai][0][m][n][j]) * acc[ai][1][m][n][j];
                u32x4 w; w.x = cvt_pk_bf16(v[0], v[1]); w.y = cvt_pk_bf16(v[2], v[3]); w.z = cvt_pk_bf16(v[4], v[5]); w.w = cvt_pk_bf16(v[6], v[7]);
                *(u32x4*)rowp = w;
            }
    }
};
struct EpiBf16 {
    static constexpr bool PERM = true;
    bf16_t* O; int ldc; const float* cbias; const float* rbias; int split_cols; size_t split_stride; bf16_t* P;
    __device__ __forceinline__ void operator()(const f32x4 (&acc)[2][2][4][2], const Unit& u, int wr, int wc, int fr, int fq) const {
        const int row0 = u.pm * BM + wr * 64 + fr; int colt = u.pn * BM; bf16_t* base = O;
        const bool part = u.ks > 0;
        if (part) base = P + (size_t)(u.ks - 1) * (2048 * DM) - (size_t)T_LAT * ldc;
        if (split_cols) { const int t = colt / split_cols; base += (size_t)t * split_stride; colt -= t * split_cols; }
        const int col0 = colt + wc * 32 + 8 * fq, bcol0 = u.pn * BM + wc * 32 + 8 * fq;
        f32x4 bv[2][2];
#pragma unroll
        for (int bj = 0; bj < 2; ++bj)
#pragma unroll
            for (int n = 0; n < 2; ++n) bv[bj][n] = (cbias && !part) ? *(const f32x4*)(cbias + bcol0 + bj * HALF + 4 * n) : (f32x4){0.f, 0.f, 0.f, 0.f};
#pragma unroll
        for (int ai = 0; ai < 2; ++ai)
#pragma unroll
            for (int m = 0; m < 4; ++m) {
                const int row = row0 + ai * HALF + m * 16;
                const float rb = rbias ? rbias[row] : 0.f;
                bf16_t* rowp = base + (size_t)row * ldc + col0;
#pragma unroll
                for (int bj = 0; bj < 2; ++bj) { f32x4 v0 = acc[ai][bj][m][0] + bv[bj][0] + rb, v1 = acc[ai][bj][m][1] + bv[bj][1] + rb;
                    u32x4 w; w.x = cvt_pk_bf16(v0[0], v0[1]); w.y = cvt_pk_bf16(v0[2], v0[3]); w.z = cvt_pk_bf16(v1[0], v1[1]); w.w = cvt_pk_bf16(v1[2], v1[3]);
                    *(u32x4*)(rowp + bj * HALF) = w; }
            }
    }
};
struct EpiGate {
    static constexpr bool PERM = false;
    unsigned* GA0; unsigned* GA1; const bf16_t* XC; const float* ba; const float* bi; const float* lam;
    __device__ __forceinline__ void operator()(const f32x4 (&acc)[2][2][4][2], const Unit& u, int wr, int wc, int fr, int fq) const {
        const int row0 = u.pm * BM + wr * 64 + fr;
        const int ch0 = (u.pn >> 2) * 256 + (u.pn & 3) * 64 + wc * 16 + fq * 4;
#pragma unroll
        for (int d = 0; d < 2; ++d) {
            unsigned* GA = d ? GA1 : GA0;
#pragma unroll
            for (int ai = 0; ai < 2; ++ai)
#pragma unroll
                for (int m = 0; m < 4; ++m) {
                    const int row = row0 + ai * HALF + m * 16;
                    const f32x4 bav = *(const f32x4*)(ba + d * DM + ch0), biv = *(const f32x4*)(bi + d * DM + ch0), spv = *(const f32x4*)(lam + d * DM + ch0);
                    const u32x2 xr = *(const u32x2*)(XC + (size_t)row * DM + ch0);
                    const float xc[4] = {bf2f(xr.x & 0xffffu), bf2f(xr.x >> 16), bf2f(xr.y & 0xffffu), bf2f(xr.y >> 16)};
                    u32x4 w;
#pragma unroll
                    for (int j = 0; j < 4; ++j) {
                        const float rr = sigmoidf_(acc[ai][d][m][0][j] + bav[j]);
                        const float ii = sigmoidf_(acc[ai][d][m][1][j] + biv[j]);
                        const float la = rr * spv[j];
                        const float bb = sqrtf(fmaxf(1.0f - __expf(2.0f * la), 0.f)) * ii * xc[j];
                        w[j] = cvt_pk_bf16(la, bb);
                    }
                    *(u32x4*)(GA + (size_t)row * DM + ch0) = w;
                    asm volatile("" ::: "memory");
                }
        }
    }
};
}

__device__ __forceinline__ void convT_tile(LAS unsigned char* lds, const float* src, int N, int K, bf16_t* dst, int mode, int aux, int tile) {
    LAS float* t = (LAS float*)lds;
    const int ntn = N / 64, tk = tile / ntn, tn = tile % ntn, k0 = tk * 64, n0 = tn * 64, tid = threadIdx.x;
    {
        const int kk = tid >> 4, n4 = (tid & 15) * 4;
#pragma unroll
        for (int p = 0; p < 2; ++p) {
            const f32x4 v = *(const f32x4*)(src + (size_t)(k0 + kk + p * 32) * N + n0 + n4);
#pragma unroll
            for (int j = 0; j < 4; ++j) t[(kk + p * 32) * 65 + n4 + j] = v[j];
        }
    }
    __syncthreads();
    {
        const int n = tid >> 3, k8 = (tid & 7) * 8, ng = n0 + n;
        int row;
        if (mode == 0) row = ng;
        else if (mode == 1) row = (ng >> 7) * 256 + (ng & 127);
        else if (mode == 2) row = (ng >> 7) * 256 + 128 + (ng & 127);
        else { const int d = aux & 1, gate = (aux >> 1) & 1, h = aux >> 2; const int pn = 4 * h + (ng >> 6), q = ng & 63;
               row = 256 * pn + 128 * d + 32 * (q >> 4) + 16 * gate + (q & 15); }
        float v[8];
#pragma unroll
        for (int j = 0; j < 8; ++j) v[j] = t[(k8 + j) * 65 + n];
        u32x4 w; w.x = pack2(v[0], v[1]); w.y = pack2(v[2], v[3]); w.z = pack2(v[4], v[5]); w.w = pack2(v[6], v[7]);
        *(u32x4*)(dst + (size_t)row * K + k0 + k8) = w;
    }
    __syncthreads();
}

__device__ __forceinline__ int conv_items(PARG p, LAS unsigned char* lds, int layer, int tile) {
    bf16_t* W = (bf16_t*)(p.ws + OFF_W);
    int base = 0;
#define CONV_MAT(SRC, NN, KK, DST, MODE, AUX) { const int cnt = ((NN) / 64) * ((KK) / 64); if (tile >= base && tile < base + cnt) { convT_tile(lds, (SRC), (NN), (KK), (DST), (MODE), (AUX), tile - base); return -1; } base += cnt; }
    for (int s = 0; s < 2; ++s) {
        const size_t o = ((size_t)layer * 2 + s) * DM * FF;
        bf16_t* w13 = W + (s ? W_13_1 : W_13_0); bf16_t* w2 = W + (s ? W_2_1 : W_2_0);
        CONV_MAT(p.in[7] + o, FF, DM, w13, 1, 0)
        CONV_MAT(p.in[8] + o, FF, DM, w13, 2, 0)
        CONV_MAT(p.in[9] + o, DM, FF, w2, 0, 0)
    }
    if (layer == 0) {
        CONV_MAT(p.in[10], 3 * DM, DM, W + W_HYIN, 0, 0)
        CONV_MAT(p.in[23], DM, DM, W + W_HYOUT, 0, 0)
    } else {
        CONV_MAT(p.in[25], 2 * DM, DM, W + W_RGIN, 0, 0)
        CONV_MAT(p.in[34], DM, DM, W + W_RGOUT, 0, 0)
        for (int d = 0; d < 2; ++d) for (int h = 0; h < 4; ++h) {
            CONV_MAT(p.in[29] + ((size_t)d * 4 + h) * 65536, 256, 256, W + W_GATE, 3, d | (0 << 1) | (h << 2))
            CONV_MAT(p.in[31] + ((size_t)d * 4 + h) * 65536, 256, 256, W + W_GATE, 3, d | (1 << 1) | (h << 2))
        }
    }
#undef CONV_MAT
    return base;
}
__device__ __forceinline__ void convert_weights(PARG p, LAS unsigned char* lds, int layer) {
    const int total = conv_items(p, lds, layer, -1);
    for (int t = blockIdx.x; t < total; t += gridDim.x) conv_items(p, lds, layer, t);
}

__device__ __forceinline__ void ada_phase(PARG p, LAS unsigned char* lds) {
    LAS float* sc = (LAS float*)lds;
    LAS float* red = sc + 9 * 1024;
    const int tid = threadIdx.x;
    bool loaded = false;
    float* MOD = (float*)(p.ws + OFF_MOD);
    for (int item = blockIdx.x; item < 288; item += gridDim.x) {
        if (!loaded) {
            for (int i = tid; i < 9 * 1024; i += 512) { const float v = (i < 8192) ? p.in[1][i] : p.in[3][i - 8192]; sc[i] = siluf_(v); }
            __syncthreads(); loaded = true;
        }
        const int l = item / 144, n0 = (item % 144) * 64, kc = tid >> 6, col = tid & 63;
        const float* w = p.in[4] + (size_t)l * DM * 9216 + n0 + col;
        float a[9];
#pragma unroll
        for (int m = 0; m < 9; ++m) a[m] = 0.f;
        for (int k = kc * 128; k < kc * 128 + 128; ++k) {
            const float wv = w[(size_t)k * 9216];
#pragma unroll
            for (int m = 0; m < 9; ++m) a[m] += sc[m * 1024 + k] * wv;
        }
#pragma unroll
        for (int m = 0; m < 9; ++m) red[(kc * 9 + m) * 64 + col] = a[m];
        __syncthreads();
        for (int i = tid; i < 9 * 64; i += 512) {
            const int m = i >> 6, c2 = i & 63; float s = 0.f;
#pragma unroll
            for (int q = 0; q < 8; ++q) s += red[(q * 9 + m) * 64 + c2];
            MOD[((size_t)l * 9 + m) * 9216 + n0 + c2] = s + p.in[5][(size_t)l * 9216 + n0 + c2];
        }
        __syncthreads();
    }
    __syncthreads();
}

__device__ __forceinline__ void filter_item(PARG p, LAS unsigned char* lds, int L, int k0, bf16_t* FT, int ldq) {
    LAS float* zf = (LAS float*)lds;
    LAS float* hA = zf + 16 * 64;
    LAS float* hB = hA + 16 * 64;
    const int tid = threadIdx.x, w = tid >> 6, lane = tid & 63;
    const float* fw0 = p.in[14]; const float* fb0 = p.in[15]; const float* fw1 = p.in[16]; const float* fb1 = p.in[17];
    const float* fw2 = p.in[18]; const float* fb2 = p.in[19]; const float* freq = p.in[20]; const float* fwout = p.in[21];
#pragma unroll 1
    for (int pp = 0; pp < 2; ++pp) {
        const int pi = w * 2 + pp, k = k0 + pi;
        float f = 0.f;
        if (lane == 0) f = (float)k / (float)(L - 1);
        else if (lane < 33) {
            const int band = (lane - 1) & 15;
            const float fr = 1e-4f + (float)band * ((15.0f - 1e-4f) / 15.0f);
            const float wk = 6.283185307179586f * (float)k / (float)L;
            const float ph = fr * wk;
            f = (lane <= 16) ? cosf(ph) : -sinf(ph);
        }
        zf[pi * 64 + lane] = f;
    }
    __syncthreads();
#pragma unroll 1
    for (int pp = 0; pp < 2; ++pp) {
        const int pi = w * 2 + pp;
        float a = fb0[lane];
#pragma unroll 3
        for (int e = 0; e < 33; ++e) a += zf[pi * 64 + e] * fw0[e * 64 + lane];
        hA[pi * 64 + lane] = sinf(freq[lane] * a);
    }
    __syncthreads();
#pragma unroll 1
    for (int pp = 0; pp < 2; ++pp) {
        const int pi = w * 2 + pp;
        float a = fb1[lane];
#pragma unroll 4
        for (int e = 0; e < 64; ++e) a += hA[pi * 64 + e] * fw1[e * 64 + lane];
        hB[pi * 64 + lane] = sinf(freq[64 + lane] * a);
    }
    __syncthreads();
#pragma unroll 1
    for (int pp = 0; pp < 2; ++pp) {
        const int pi = w * 2 + pp;
        float a = fb2[lane];
#pragma unroll 4
        for (int e = 0; e < 64; ++e) a += hB[pi * 64 + e] * fw2[e * 64 + lane];
        hA[pi * 64 + lane] = sinf(freq[128 + lane] * a);
    }
    __syncthreads();
    const float min_decay = -3.0701134573253945f, max_decay = -15.350567286626973f;
#pragma unroll 1
    for (int q = 0; q < 4; ++q) {
        const int n = tid + 512 * q;
        float acc[16];
#pragma unroll
        for (int i = 0; i < 16; ++i) acc[i] = 0.f;
#pragma unroll 2
        for (int e = 0; e < 64; ++e) {
            const float wv = fwout[e * 2048 + n];
#pragma unroll
            for (int i = 0; i < 16; ++i) acc[i] += hA[i * 64 + e] * wv;
        }
        const int c = n & 1023; const bool bwd = n >= 1024;
        const float delta = fabsf(min_decay + (float)c * ((max_decay - min_decay) / 1023.0f));
        bf16_t* dst = FT + (size_t)c * ldq;
#pragma unroll
        for (int i = 0; i < 16; ++i) {
            const int k = k0 + i;
            const float tk = (float)k / (float)(L - 1);
            const float val = acc[i] * __expf(-tk * delta);
            if (!bwd) dst[(L - 1) - k] = (bf16_t)f2bf(val);
            else if (k >= 1) dst[(L - 1) + k] = (bf16_t)f2bf(val);
        }
        if (k0 == 0 && !bwd) dst[2 * L - 1] = 0;
    }
    __syncthreads();
}
__device__ __forceinline__ void filter_phase(PARG p, LAS unsigned char* lds) {
    for (int item = (int)gridDim.x - 1 - (int)blockIdx.x; item < 144; item += gridDim.x) {
        if (item < 128) filter_item(p, lds, SEQ, item * 16, (bf16_t*)(p.ws + OFF_FILT), 4096);
        else filter_item(p, lds, CTXL, (item - 128) * 16, (bf16_t*)(p.ws + OFF_FILTC), 512);
    }
}

struct EwArgs { int init; int has_h; int nrows; float coef; int lres, gate_i, gpost_i; int lh, gpre_i, shift_i, scale_i; int nks; };
__device__ __forceinline__ float* xrow_ptr(PARG p, int row) { return row < T_LAT ? p.out + (size_t)row * DM : (float*)(p.ws + OFF_XS) + (size_t)(row - T_LAT) * DM; }
__device__ __forceinline__ void ew_phase(PARG p, const EwArgs a) {
    const int lane = threadIdx.x & 63, wv = threadIdx.x >> 6;
    const float* MOD = (const float*)(p.ws + OFF_MOD);
    const float* NG = p.in[6];
    const bf16_t* Y = (const bf16_t*)(p.ws + OFF_Y);
    bf16_t* H = (bf16_t*)(p.ws + OFF_H);
    for (int row = blockIdx.x * 8 + wv; row < a.nrows; row += gridDim.x * 8) {
        const int midx = row < T_LAT ? (row >> 11) : 8;
        float* xp = xrow_ptr(p, row);
        f32x4 x[4], g[4], sh[4], scl[4];
        if (a.has_h) {
#pragma unroll
            for (int q = 0; q < 4; ++q) {
                const int col = q * 256 + lane * 4;
                g[q] = *(const f32x4*)(NG + ((size_t)a.lh * 6 + a.gpre_i) * DM + col);
                sh[q] = *(const f32x4*)(MOD + ((size_t)a.lh * 9 + midx) * 9216 + a.shift_i * DM + col);
                scl[q] = *(const f32x4*)(MOD + ((size_t)a.lh * 9 + midx) * 9216 + a.scale_i * DM + col);
            }
        }
        if (a.init) {
            if (row < T_LAT) {
                const int t = row & (SEQ - 1); const float pr = (float)(t >> 6), pc = (float)(t & 63);
#pragma unroll
                for (int q = 0; q < 4; ++q) {
                    const int col = q * 256 + lane * 4;
                    f32x4 v = *(const f32x4*)(p.in[0] + (size_t)row * DM + col);
#pragma unroll
                    for (int j = 0; j < 4; ++j) {
                        const int d = col + j, i = d & 255;
                        const float om = __expf(-(float)i * (9.210340371976184f / 256.0f));
                        const float ang = ((d < 512) ? pr : pc) * om;
                        v[j] += ((d >> 8) & 1) ? cosf(ang) : sinf(ang);
                    }
                    x[q] = v;
                }
            } else {
#pragma unroll
                for (int q = 0; q < 4; ++q) x[q] = *(const f32x4*)(p.in[2] + (size_t)(row - T_LAT) * DM + q * 256 + lane * 4);
            }
        } else {
            f32x4 y[4], gt[4], gp[4]; u32x2 yr[4]; float ss = 0.f;
#pragma unroll
            for (int q = 0; q < 4; ++q) {
                const int col = q * 256 + lane * 4;
                x[q] = *(const f32x4*)(xp + col);
                yr[q] = *(const u32x2*)(Y + (size_t)row * DM + col);
                gt[q] = *(const f32x4*)(MOD + ((size_t)a.lres * 9 + midx) * 9216 + a.gate_i * DM + col);
                gp[q] = *(const f32x4*)(NG + ((size_t)a.lres * 6 + a.gpost_i) * DM + col);
            }
#pragma unroll
            for (int q = 0; q < 4; ++q) {
                y[q] = (f32x4){bf2f(yr[q].x & 0xffffu), bf2f(yr[q].x >> 16), bf2f(yr[q].y & 0xffffu), bf2f(yr[q].y >> 16)};
                if (row >= T_LAT) for (int k = 0; k + 1 < a.nks; ++k) {
                    const u32x2 pr2 = *(const u32x2*)((const bf16_t*)(p.ws + OFF_YP) + ((size_t)k * 2048 + (row - T_LAT)) * DM + q * 256 + lane * 4);
                    y[q] = y[q] + (f32x4){bf2f(pr2.x & 0xffffu), bf2f(pr2.x >> 16), bf2f(pr2.y & 0xffffu), bf2f(pr2.y >> 16)};
                }
#pragma unroll
                for (int j = 0; j < 4; ++j) ss += y[q][j] * y[q][j];
            }
            ss = wave_sum(ss);
            const float r = a.coef * rsqrtf(ss * (1.0f / DM) + 1e-6f);
#pragma unroll
            for (int q = 0; q < 4; ++q) x[q] = x[q] + (r * gt[q]) * (y[q] * gp[q]);
        }
#pragma unroll
        for (int q = 0; q < 4; ++q) *(f32x4*)(xp + q * 256 + lane * 4) = x[q];
        if (a.has_h) {
            float ss = 0.f;
#pragma unroll
            for (int q = 0; q < 4; ++q)
#pragma unroll
                for (int j = 0; j < 4; ++j) ss += x[q][j] * x[q][j];
            ss = wave_sum(ss);
            const float r = rsqrtf(ss * (1.0f / DM) + 1e-6f);
#pragma unroll
            for (int q = 0; q < 4; ++q) {
                const int col = q * 256 + lane * 4;
                const f32x4 h = (x[q] * r) * g[q] * (scl[q] + 1.0f) + sh[q];
                u32x2 w; w.x = pack2(h[0], h[1]); w.y = pack2(h[2], h[3]);
                *(u32x2*)(H + (size_t)row * DM + col) = w;
            }
        }
    }
}

template <int L>
__device__ __forceinline__ void longconv_channel(PARG p, LAS unsigned char* lds, int c) {
    constexpr int NBLK = L / 64, NCOL = NBLK * 8, FLEN = 2 * L, CSTRIDE = FLEN * 2 + 32, ZSTRIDE = 144;
    constexpr int Z_OFF = 8 * CSTRIDE;
    constexpr int MB = (L == SEQ) ? 4 : 1, CBW = (L == SEQ) ? 2 : 1;
    static_assert(Z_OFF + NCOL * ZSTRIDE <= LDS_MAIN, "lds");
    const int tid = threadIdx.x, wid = tid >> 6, lane = tid & 63, fr = lane & 15, fq = lane >> 4;
    const int tok0 = (L == SEQ) ? 0 : T_LAT;
    const bf16_t* UT = (const bf16_t*)(p.ws + OFF_BIG);
    const bf16_t* FT = (L == SEQ) ? (const bf16_t*)(p.ws + OFF_FILT) + (size_t)c * 4096 : (const bf16_t*)(p.ws + OFF_FILTC) + (size_t)c * 512;
    bf16_t* YT = (bf16_t*)(p.ws + OFF_Y);
    const float* cw = p.in[12]; const float* cb = p.in[13];
    for (int v = tid; v < FLEN / 8; v += 512) *(LAS u32x4*)(lds + v * 16) = *(const u32x4*)(FT + v * 8);
    {
        const float w10 = cw[0 * 3072 + 1024 + c], w11 = cw[1 * 3072 + 1024 + c], w12 = cw[2 * 3072 + 1024 + c], b1 = cb[1024 + c];
        const float w20 = cw[0 * 3072 + 2048 + c], w21 = cw[1 * 3072 + 2048 + c], w22 = cw[2 * 3072 + 2048 + c], b2 = cb[2048 + c];
        const bf16_t* r1 = UT + (size_t)(1024 + c) * T_ALL + tok0; const bf16_t* r2 = UT + (size_t)(2048 + c) * T_ALL + tok0;
        for (int g = tid; g < NB * L / 8; g += 512) {
            const int b = g / (L / 8), t0 = (g % (L / 8)) * 8;
            const size_t o = (size_t)b * L + t0;
            const u32x4 a = *(const u32x4*)(r1 + o); const u32x4 bq = *(const u32x4*)(r2 + o);
            float x1[10], x2[10];
            x1[0] = t0 > 0 ? bf2f(r1[o - 1]) : 0.f; x2[0] = t0 > 0 ? bf2f(r2[o - 1]) : 0.f;
            x1[9] = t0 + 8 < L ? bf2f(r1[o + 8]) : 0.f; x2[9] = t0 + 8 < L ? bf2f(r2[o + 8]) : 0.f;
#pragma unroll
            for (int j = 0; j < 4; ++j) { x1[1 + 2 * j] = bf2f(a[j] & 0xffffu); x1[2 + 2 * j] = bf2f(a[j] >> 16); x2[1 + 2 * j] = bf2f(bq[j] & 0xffffu); x2[2 + 2 * j] = bf2f(bq[j] >> 16); }
            float z[8];
#pragma unroll
            for (int j = 0; j < 8; ++j) z[j] = (b1 + w10 * x1[j] + w11 * x1[j + 1] + w12 * x1[j + 2]) * (b2 + w20 * x2[j] + w21 * x2[j + 1] + w22 * x2[j + 2]);
            u32x4 w; w.x = pack2(z[0], z[1]); w.y = pack2(z[2], z[3]); w.z = pack2(z[4], z[5]); w.w = pack2(z[6], z[7]);
            *(LAS u32x4*)(lds + Z_OFF + ((t0 >> 6) * 8 + b) * ZSTRIDE + (t0 & 63) * 2) = w;
        }
    }
    __syncthreads();
    {
        const LAS unsigned* D = (const LAS unsigned*)lds;
        for (int v = tid; v < FLEN / 8; v += 512) {
            unsigned d[8];
#pragma unroll
            for (int i = 0; i < 8; ++i) d[i] = D[4 * v + i];
#pragma unroll
            for (int j = 1; j < 8; ++j) {
                u32x4 w;
#pragma unroll
                for (int i = 0; i < 4; ++i) w[i] = (j & 1) ? __builtin_amdgcn_alignbyte(d[i + (j + 1) / 2], d[i + (j - 1) / 2], 2) : d[i + j / 2];
                *(LAS u32x4*)(lds + j * CSTRIDE + v * 16) = w;
            }
        }
    }
    __syncthreads();
    const int mb0 = (L == SEQ) ? 0 : (wid & 3), cb0 = (L == SEQ) ? 2 * wid : (wid >> 2);
    f32x4 acc[CBW][MB];
#pragma unroll
    for (int x = 0; x < CBW; ++x)
#pragma unroll
        for (int m = 0; m < MB; ++m) acc[x][m] = (f32x4){0.f, 0.f, 0.f, 0.f};
    const int jj = (7 - fr) & 7;
    const int abase = jj * CSTRIDE + 2 * ((L - 1) - fr - jj + 8 * fq);
    const int ilo = 2 * cb0, ihi = 2 * (cb0 + CBW) - 1;
    for (int d = ilo - (NBLK - 1); d <= ihi; ++d) {
        bf16x8 af[MB][2];
#pragma unroll
        for (int m = 0; m < MB; ++m)
#pragma unroll
            for (int k = 0; k < 2; ++k) af[m][k] = *(const LAS bf16x8*)(lds + abase + 2 * (-64 * d - 16 * (mb0 + m) + 32 * k));
#pragma unroll
        for (int x = 0; x < CBW; ++x) {
            const int col = 16 * (cb0 + x) + fr, ip = (col >> 3) - d;
            const bool ok = (ip >= 0) && (ip < NBLK);
            const int colp = ok ? col - 8 * d : col;
            bf16x8 bfr[2];
#pragma unroll
            for (int k = 0; k < 2; ++k) {
                bf16x8 v = *(const LAS bf16x8*)(lds + Z_OFF + colp * ZSTRIDE + (32 * k + 8 * fq) * 2);
                if (!ok) v = (bf16x8){0, 0, 0, 0, 0, 0, 0, 0};
                bfr[k] = v;
            }
#pragma unroll
            for (int m = 0; m < MB; ++m)
#pragma unroll
                for (int k = 0; k < 2; ++k) acc[x][m] = __builtin_amdgcn_mfma_f32_16x16x32_bf16(af[m][k], bfr[k], acc[x][m], 0, 0, 0);
        }
    }
    {
        const float w00 = cw[0 * 3072 + c], w01 = cw[1 * 3072 + c], w02 = cw[2 * 3072 + c], b0 = cb[c], fbias = p.in[22][c];
        const bf16_t* r0 = UT + (size_t)c * T_ALL + tok0;
#pragma unroll
        for (int x = 0; x < CBW; ++x)
#pragma unroll
            for (int m = 0; m < MB; ++m) {
                const int col = 16 * (cb0 + x) + fr, i = col >> 3, b = col & 7, r = 16 * (mb0 + m) + 4 * fq, t = 64 * i + r;
                const size_t o = (size_t)b * L + t;
                const u32x2 xr = *(const u32x2*)(r0 + o);
                float xv[6];
                xv[0] = t > 0 ? bf2f(r0[o - 1]) : 0.f; xv[5] = t + 4 < L ? bf2f(r0[o + 4]) : 0.f;
                xv[1] = bf2f(xr.x & 0xffffu); xv[2] = bf2f(xr.x >> 16); xv[3] = bf2f(xr.y & 0xffffu); xv[4] = bf2f(xr.y >> 16);
                const u32x2 zr = *(const LAS u32x2*)(lds + Z_OFF + col * ZSTRIDE + r * 2);
                const float zv[4] = {bf2f(zr.x & 0xffffu), bf2f(zr.x >> 16), bf2f(zr.y & 0xffffu), bf2f(zr.y >> 16)};
                float o4[4];
#pragma unroll
                for (int j = 0; j < 4; ++j) o4[j] = (b0 + w00 * xv[j] + w01 * xv[j + 1] + w02 * xv[j + 2]) * (acc[x][m][j] + fbias * zv[j]);
                u32x2 w; w.x = pack2(o4[0], o4[1]); w.y = pack2(o4[2], o4[3]);
                *(u32x2*)(YT + (size_t)c * T_ALL + tok0 + o) = w;
            }
    }
    __syncthreads();
}
__device__ __forceinline__ void longconv_phase(PARG p, LAS unsigned char* lds) {
    for (int c = blockIdx.x; c < DM; c += gridDim.x) longconv_channel<SEQ>(p, lds, c);
    for (int c = blockIdx.x; c < DM; c += gridDim.x) longconv_channel<CTXL>(p, lds, c);
}

__device__ __forceinline__ void transpose_phase(PARG p, LAS unsigned char* lds) {
    const bf16_t* S = (const bf16_t*)(p.ws + OFF_Y); bf16_t* Dst = (bf16_t*)(p.ws + OFF_H);
    LAS bf16_t* t = (LAS bf16_t*)lds;
    const int tid = threadIdx.x;
    for (int item = blockIdx.x; item < 16 * (T_ALL / 64); item += gridDim.x) {
        const int c0 = (item & 15) * 64, t0 = (item >> 4) * 64;
        { const int c = tid >> 3, t8 = (tid & 7) * 8;
          *(LAS u32x4*)(t + c * 72 + t8) = *(const u32x4*)(S + (size_t)(c0 + c) * T_ALL + t0 + t8); }
        __syncthreads();
        { const int tt = tid >> 3, c8 = (tid & 7) * 8;
          unsigned v[8];
#pragma unroll
          for (int j = 0; j < 8; ++j) v[j] = t[(c8 + j) * 72 + tt];
          u32x4 w; w.x = v[0] | (v[1] << 16); w.y = v[2] | (v[3] << 16); w.z = v[4] | (v[5] << 16); w.w = v[6] | (v[7] << 16);
          *(u32x4*)(Dst + (size_t)(t0 + tt) * DM + c0 + c8) = w; }
        __syncthreads();
    }
}

__device__ __forceinline__ void rgconv_phase(PARG p) {
    const bf16_t* R = (const bf16_t*)(p.ws + OFF_BIG + 37748736); bf16_t* XC = (bf16_t*)(p.ws + OFF_H);
    const float* cw = p.in[27]; const float* cb = p.in[28];
    for (int it = blockIdx.x * 512 + threadIdx.x; it < T_ALL * 128; it += gridDim.x * 512) {
        const int row = it >> 7, c8 = (it & 127) * 8;
        int t, L;
        if (row < T_LAT) { t = row & (SEQ - 1); L = SEQ; } else { t = (row - T_LAT) & (CTXL - 1); L = CTXL; }
        float o[8];
#pragma unroll
        for (int j = 0; j < 8; ++j) o[j] = cb[c8 + j];
#pragma unroll
        for (int k = 0; k < 4; ++k) {
            const int tt = t + k - 1;
            if (tt >= 0 && tt < L) {
                const u32x4 v = *(const u32x4*)(R + (size_t)(row + k - 1) * DM + c8);
                const f32x4 w0 = *(const f32x4*)(cw + k * DM + c8), w1 = *(const f32x4*)(cw + k * DM + c8 + 4);
#pragma unroll
                for (int j = 0; j < 4; ++j) { const float lo = bf2f(v[j] & 0xffffu), hi = bf2f(v[j] >> 16);
                    o[2 * j] += lo * (j < 2 ? w0[2 * j] : w1[2 * j - 4]); o[2 * j + 1] += hi * (j < 2 ? w0[2 * j + 1] : w1[2 * j - 3]); }
            }
        }
        u32x4 w; w.x = pack2(o[0], o[1]); w.y = pack2(o[2], o[3]); w.z = pack2(o[4], o[5]); w.w = pack2(o[6], o[7]);
        *(u32x4*)(XC + (size_t)row * DM + c8) = w;
    }
}

__device__ __forceinline__ int scan_row(int dir, int b, int q) {
    if (q < CTXL) return T_LAT + b * CTXL + (dir ? (CTXL - 1 - q) : q);
    const int t = q - CTXL; return b * SEQ + (dir ? (SEQ - 1 - t) : t);
}
__device__ __forceinline__ void scan_agg_phase(PARG p) {
    const unsigned* GA0 = (const unsigned*)(p.ws + OFF_BIG + 37748736); const unsigned* GA1 = (const unsigned*)(p.ws + OFF_EXTRA);
    f32x2* AGG = (f32x2*)(p.ws + OFF_Y);
    const int lane = threadIdx.x & 63, wv = threadIdx.x >> 6;
    for (int item = blockIdx.x * 8 + wv; item < 2 * 8 * 36 * 16; item += gridDim.x * 8) {
        const int cg_ = item & 15, k = (item >> 4) % 36, b = ((item >> 4) / 36) & 7, dir = (item >> 4) / 288;
        const int ch = cg_ * 64 + lane;
        const unsigned* GA = dir ? GA1 : GA0;
        const int r0 = scan_row(dir, b, 64 * k); const int step = dir ? -1 : 1;
        float A = 1.f, Bv = 0.f;
#pragma unroll 16
        for (int s = 0; s < 64; ++s) {
            const unsigned v = GA[(size_t)(r0 + step * s) * DM + ch];
            const float a = __expf(bf2f(v & 0xffffu)), bb = bf2f(v >> 16);
            A *= a; Bv = a * Bv + bb;
        }
        AGG[(((size_t)dir * 8 + b) * 36 + k) * DM + ch] = (f32x2){A, Bv};
    }
}
__device__ __forceinline__ void scan_out_phase(PARG p) {
    const unsigned* GA0 = (const unsigned*)(p.ws + OFF_BIG + 37748736); const unsigned* GA1 = (const unsigned*)(p.ws + OFF_EXTRA);
    const f32x2* AGG = (const f32x2*)(p.ws + OFF_Y);
    const bf16_t* G = (const bf16_t*)(p.ws + OFF_BIG);
    bf16_t* H = (bf16_t*)(p.ws + OFF_H);
    const int lane = threadIdx.x & 63, wv = threadIdx.x >> 6;
    for (int item = blockIdx.x * 8 + wv; item < 8 * 32 * 16; item += gridDim.x * 8) {
        const int cg_ = item & 15, kl = (item >> 4) & 31, b = item >> 9;
        const int ch = cg_ * 64 + lane;
        float hf = 0.f, hr = 0.f;
        { const f32x2* ag = AGG + ((size_t)0 * 8 + b) * 36 * DM + ch; const int n = 4 + kl;
          for (int k = 0; k < n; ++k) { const f32x2 v = ag[(size_t)k * DM]; hf = v.x * hf + v.y; } }
        { const f32x2* ag = AGG + ((size_t)1 * 8 + b) * 36 * DM + ch; const int n = 4 + (31 - kl);
          for (int k = 0; k < n; ++k) { const f32x2 v = ag[(size_t)k * DM]; hr = v.x * hr + v.y; } }
        const int row0 = b * SEQ + kl * 64;
        float hs[64];
#pragma unroll
        for (int s = 0; s < 64; ++s) {
            const unsigned v = GA0[(size_t)(row0 + s) * DM + ch];
            hf = __expf(bf2f(v & 0xffffu)) * hf + bf2f(v >> 16); hs[s] = hf;
        }
#pragma unroll
        for (int s = 63; s >= 0; --s) {
            const unsigned v = GA1[(size_t)(row0 + s) * DM + ch];
            hr = __expf(bf2f(v & 0xffffu)) * hr + bf2f(v >> 16);
            const float g = bf2f(G[(size_t)(row0 + s) * DM + ch]);
            H[(size_t)(row0 + s) * DM + ch] = (bf16_t)f2bf((hs[s] + hr) * geluf_(g));
        }
    }
}


#define XB_TMO      128
#define XB_XCNT(j)  (256  + 64 * (j))
#define XB_XSUB(j)  (1280 + 64 * (j))
#define XB_XGEN(j)  (2304 + 64 * (j))
#define XB_TOP      3328
#define XB_TOPGEN   3392
#define XCD_BAR_WORDS 3456
#define XB_SPIN_CAP (1u << 18)
__device__ __forceinline__ unsigned xb_ld(unsigned* p)              { return __hip_atomic_load(p, __ATOMIC_RELAXED, __HIP_MEMORY_SCOPE_AGENT); }
__device__ __forceinline__ unsigned xb_add(unsigned* p, unsigned v) { return __hip_atomic_fetch_add(p, v, __ATOMIC_RELAXED, __HIP_MEMORY_SCOPE_AGENT); }
__device__ __forceinline__ unsigned xb_xcc_id() { return (unsigned)__builtin_amdgcn_s_getreg((3 << 11) | 20) & 0xFu; }
#define XB_SPIN(cond, bar) do { unsigned _sp = 0; while (cond) { __builtin_amdgcn_s_sleep(1); \
    if ((++_sp & 255u) == 0u) { if (xb_ld(&(bar)[XB_TMO])) break; if (_sp > XB_SPIN_CAP) { atomicAdd(&(bar)[XB_TMO], 1u); break; } } } } while (0)
struct XcdBarrier { unsigned* bar; unsigned x; volatile LAS unsigned* st; };
__device__ __forceinline__ XcdBarrier xcd_barrier_post(unsigned* bar, volatile LAS unsigned* st) {
    XcdBarrier b; b.bar = bar; b.x = xb_xcc_id(); b.st = st;
    if (threadIdx.x == 0) (void)xb_add(&bar[XB_XCNT(b.x)], 1u);
    return b;
}
__device__ __forceinline__ void xcd_barrier_complete(unsigned* bar, unsigned x, unsigned& nloc, unsigned& nx) {
    const unsigned G = gridDim.x * gridDim.y * gridDim.z;
    unsigned sum, cnt, mine, sp = 0u;
    for (;;) {
        sum = 0u; cnt = 0u; mine = 0u;
#pragma unroll
        for (unsigned j = 0; j < 16; ++j) { const unsigned c = xb_ld(&bar[XB_XCNT(j)]); sum += c; cnt += (c > 0u) ? 1u : 0u; mine = (j == x) ? c : mine; }
        if (sum == G) break;
        __builtin_amdgcn_s_sleep(1);
        if ((++sp & 255u) == 0u) { if (xb_ld(&bar[XB_TMO])) break; if (sp > XB_SPIN_CAP) { atomicAdd(&bar[XB_TMO], 1u); break; } }
    }
    nloc = mine > 0u ? mine : 1u; nx = cnt > 0u ? cnt : 1u;
}
__device__ __forceinline__ void xcd_barrier(const XcdBarrier& b) {
    asm volatile("s_waitcnt vmcnt(0)" ::: "memory");
    __syncthreads();
    if (threadIdx.x == 0) {
        unsigned* bar = b.bar;
        __builtin_amdgcn_s_waitcnt(0);
        unsigned nloc = b.st[0], nx = b.st[1];
        if (nloc == 0u) { xcd_barrier_complete(bar, b.x, nloc, nx); b.st[0] = nloc; b.st[1] = nx; }
        const unsigned old = xb_add(&bar[XB_XSUB(b.x)], 1u);
        const unsigned gen = old / nloc;
        if (old + 1u == (gen + 1u) * nloc) {
            __builtin_amdgcn_fence(__ATOMIC_RELEASE, "agent");
            asm volatile("s_waitcnt vmcnt(0)" ::: "memory");
            const unsigned og = xb_add(&bar[XB_TOP], 1u);
            const unsigned tg = og / nx;
            if (og + 1u == (tg + 1u) * nx) xb_add(&bar[XB_TOPGEN], 1u);
            else XB_SPIN(xb_ld(&bar[XB_TOPGEN]) == tg, bar);
            __builtin_amdgcn_fence(__ATOMIC_ACQUIRE, "agent");
            xb_add(&bar[XB_XGEN(b.x)], 1u);
            asm volatile("s_waitcnt vmcnt(0)" ::: "memory");
        } else {
            XB_SPIN(xb_ld(&bar[XB_XGEN(b.x)]) == gen, bar);
            __builtin_amdgcn_fence(__ATOMIC_ACQUIRE, "agent");
            asm volatile("s_waitcnt vmcnt(0)" ::: "memory");
        }
    }
    __syncthreads();
}

__device__ __forceinline__ void run_gemm1(PARG p, LAS unsigned char* lds, int s, int M) {
    const bf16_t* W = (const bf16_t*)(p.ws + OFF_W);
    pg8::Gemm g{(const bf16_t*)(p.ws + OFF_H), W + (s ? W_13_1 : W_13_0), M, 2 * FF, DM, DM, DM, 1 << 20, 0};
    pg8::StaticOrder S; S.init(T_LAT, g.N, g.K, gridDim.x, blockIdx.x, (M - T_LAT) / 256, 1);
    pg8::EpiSwiglu E{(bf16_t*)(p.ws + OFF_BIG)};
    pg8::gemm_phase(lds, g, S, E);
}
__device__ __forceinline__ void run_gemm2(PARG p, LAS unsigned char* lds, int s, int M) {
    const bf16_t* W = (const bf16_t*)(p.ws + OFF_W);
    pg8::Gemm g{(const bf16_t*)(p.ws + OFF_BIG), W + (s ? W_2_1 : W_2_0), M, DM, FF, FF, FF, 1 << 20, 0};
    pg8::StaticOrder S; S.init(T_LAT, g.N, g.K, gridDim.x, blockIdx.x, (M - T_LAT) / 256, 2);
    pg8::EpiBf16 E{(bf16_t*)(p.ws + OFF_Y), DM, nullptr, nullptr, 0, 0, (bf16_t*)(p.ws + OFF_YP)};
    pg8::gemm_phase(lds, g, S, E);
}

#ifndef PHSEL
#define PHSEL -1
#endif
__device__ __forceinline__ void run_phase(PARG p, LAS unsigned char* lds, int ph) {
    const bf16_t* W = (const bf16_t*)(p.ws + OFF_W);
    switch (ph) {
    case 0: if (PHSEL >= 0 && PHSEL != 0) break; ada_phase(p, lds); filter_phase(p, lds); convert_weights(p, lds, 0); break;
    case 1: if (PHSEL >= 0 && PHSEL != 1) break; ew_phase(p, EwArgs{1, 1, T_ALL, 0.f, 0, 0, 0, 0, 0, 0, 1, 1}); break;
    case 2: if (PHSEL >= 0 && PHSEL != 2) break; run_gemm1(p, lds, 0, T_ALL); break;
    case 3: if (PHSEL >= 0 && PHSEL != 3) break; run_gemm2(p, lds, 0, T_ALL); break;
    case 4: if (PHSEL >= 0 && PHSEL != 4) break; ew_phase(p, EwArgs{0, 1, T_ALL, 0.5f, 0, 2, 1, 0, 2, 3, 4, 2}); break;
    case 5: if (PHSEL >= 0 && PHSEL != 5) break; {
        pg8::Gemm g{W + W_HYIN, (const bf16_t*)(p.ws + OFF_H), 3 * DM, T_ALL, DM, DM, DM, 1 << 20, 0};
        pg8::StaticOrder S; S.init(g.M, g.N, g.K, gridDim.x, blockIdx.x, 0, 1);
        pg8::EpiBf16 E{(bf16_t*)(p.ws + OFF_BIG), T_ALL, nullptr, p.in[11], 0, 0, nullptr};
        pg8::gemm_phase(lds, g, S, E);
    } break;
    case 6: if (PHSEL >= 0 && PHSEL != 6) break; longconv_phase(p, lds); break;
    case 7: if (PHSEL >= 0 && PHSEL != 7) break; transpose_phase(p, lds); break;
    case 8: if (PHSEL >= 0 && PHSEL != 8) break; {
        pg8::Gemm g{(const bf16_t*)(p.ws + OFF_H), W + W_HYOUT, T_ALL, DM, DM, DM, DM, 1 << 20, 0};
        pg8::StaticOrder S; S.init(T_LAT, g.N, g.K, gridDim.x, blockIdx.x, 8, 4);
        pg8::EpiBf16 E{(bf16_t*)(p.ws + OFF_Y), DM, p.in[24], nullptr, 0, 0, (bf16_t*)(p.ws + OFF_YP)};
        pg8::gemm_phase(lds, g, S, E);
    } break;
    case 9: if (PHSEL >= 0 && PHSEL != 9) break; ew_phase(p, EwArgs{0, 1, T_ALL, 1.0f, 0, 5, 3, 0, 4, 6, 7, 4}); break;
    case 10: if (PHSEL >= 0 && PHSEL != 10) break; run_gemm1(p, lds, 1, T_ALL); break;
    case 11: if (PHSEL >= 0 && PHSEL != 11) break; run_gemm2(p, lds, 1, T_ALL); break;
    case 12: if (PHSEL >= 0 && PHSEL != 12) break; ew_phase(p, EwArgs{0, 1, T_ALL, 0.5f, 0, 8, 5, 1, 0, 0, 1, 2}); convert_weights(p, lds, 1);
        if (blockIdx.x == gridDim.x - 1) for (int i = threadIdx.x; i < 2 * DM; i += 512) ((float*)(p.ws + OFF_SP8))[i] = -8.0f * log1pf(__expf(-p.in[33][i]));
        break;
    case 13: if (PHSEL >= 0 && PHSEL != 13) break; run_gemm1(p, lds, 0, T_ALL); break;
    case 14: if (PHSEL >= 0 && PHSEL != 14) break; run_gemm2(p, lds, 0, T_ALL); break;
    case 15: if (PHSEL >= 0 && PHSEL != 15) break; ew_phase(p, EwArgs{0, 1, T_ALL, 0.5f, 1, 2, 1, 1, 2, 3, 4, 2}); break;
    case 16: if (PHSEL >= 0 && PHSEL != 16) break; {
        pg8::Gemm g{(const bf16_t*)(p.ws + OFF_H), W + W_RGIN, T_ALL, 2 * DM, DM, DM, DM, 1 << 20, 0};
        pg8::StaticOrder S; S.init(T_LAT, g.N, g.K, gridDim.x, blockIdx.x, 8, 1);
        pg8::EpiBf16 E{(bf16_t*)(p.ws + OFF_BIG), DM, p.in[26], nullptr, DM, (size_t)T_ALL * DM, nullptr};
        pg8::gemm_phase(lds, g, S, E);
    } break;
    case 17: if (PHSEL >= 0 && PHSEL != 17) break; rgconv_phase(p); break;
    case 18: if (PHSEL >= 0 && PHSEL != 18) break; {
        pg8::Gemm g{(const bf16_t*)(p.ws + OFF_H), W + W_GATE, T_ALL, 4096, 256, DM, 256, 4, 256};
        pg8::StaticOrder S; S.init(T_LAT, g.N, g.K, gridDim.x, blockIdx.x, 8, 1);
        pg8::EpiGate E{(unsigned*)(p.ws + OFF_BIG + 37748736), (unsigned*)(p.ws + OFF_EXTRA), (const bf16_t*)(p.ws + OFF_H), p.in[30], p.in[32], (const float*)(p.ws + OFF_SP8)};
        pg8::gemm_phase(lds, g, S, E);
    } break;
    case 19: if (PHSEL >= 0 && PHSEL != 19) break; scan_agg_phase(p); break;
    case 20: if (PHSEL >= 0 && PHSEL != 20) break; scan_out_phase(p); break;
    case 21: if (PHSEL >= 0 && PHSEL != 21) break; {
        pg8::Gemm g{(const bf16_t*)(p.ws + OFF_H), W + W_RGOUT, T_LAT, DM, DM, DM, DM, 1 << 20, 0};
        pg8::StaticOrder S; S.init(T_LAT, g.N, g.K, gridDim.x, blockIdx.x, 0, 1);
        pg8::EpiBf16 E{(bf16_t*)(p.ws + OFF_Y), DM, p.in[35], nullptr, 0, 0, nullptr};
        pg8::gemm_phase(lds, g, S, E);
    } break;
    case 22: if (PHSEL >= 0 && PHSEL != 22) break; ew_phase(p, EwArgs{0, 1, T_LAT, 1.0f, 1, 5, 3, 1, 4, 6, 7, 1}); break;
    case 23: if (PHSEL >= 0 && PHSEL != 23) break; run_gemm1(p, lds, 1, T_LAT); break;
    case 24: if (PHSEL >= 0 && PHSEL != 24) break; run_gemm2(p, lds, 1, T_LAT); break;
    case 25: if (PHSEL >= 0 && PHSEL != 25) break; ew_phase(p, EwArgs{0, 0, T_LAT, 0.5f, 1, 8, 5, 0, 0, 0, 0, 1}); break;
    default: break;
    }
}

__global__ void __launch_bounds__(512, 2) mega_kernel(Params p) {
    extern __shared__ __attribute__((aligned(16))) unsigned char shm[];
    LAS unsigned char* lds = (LAS unsigned char*)shm;
    cg::grid_group grid = cg::this_grid();
    typedef const __attribute__((address_space(4))) Params* KP;
    const KP kp = (KP)__builtin_amdgcn_kernarg_segment_ptr();
    volatile LAS unsigned* st = (volatile LAS unsigned*)(lds + LDS_MAIN);
    if (threadIdx.x == 0) { st[0] = 0u; st[1] = 0u; }
    __syncthreads();
    XcdBarrier xb; xb.bar = nullptr; xb.x = 0; xb.st = st;
    if (kp->ph_hi - kp->ph_lo > 1) xb = xcd_barrier_post((unsigned*)(kp->ws + OFF_BAR), st);
    if (kp->ph_hi > 4096) grid.sync();
#define PH(k) { KP q = kp; asm volatile("" : "+s"(q)); const int lo_ = q->ph_lo, hi_ = q->ph_hi; if (lo_ <= (k) && (k) < hi_) { run_phase(*q, lds, (k)); if ((REPEAT_MASK >> (k)) & 1u) { xcd_barrier(xb); run_phase(*q, lds, (k)); } if ((k) + 1 < hi_) xcd_barrier(xb); } }
    PH(0) PH(1) PH(2) PH(3) PH(4) PH(5) PH(6) PH(7) PH(8) PH(9) PH(10) PH(11) PH(12) PH(13) PH(14) PH(15) PH(16) PH(17) PH(18) PH(19) PH(20) PH(21) PH(22) PH(23) PH(24) PH(25)
#undef PH
}

#ifndef N_LAUNCH_MODE
#define N_LAUNCH_MODE 0
#endif

extern "C" void kernel_launch(void* const* d_in, const int* in_sizes, int n_in, void* d_out, int out_size, void* d_ws, size_t ws_size, hipStream_t stream) {
    static int grid = 0;
    if (grid == 0) {
        if (n_in != 36 || ws_size < WS_END) { fprintf(stderr, "kernel_launch: unexpected n_in %d / ws_size %zu (need %zu)\n", n_in, ws_size, (size_t)WS_END); grid = -1; return; }
        int dev = 0, cus = 0, per_cu = 0;
        hipGetDevice(&dev);
        hipDeviceGetAttribute(&cus, hipDeviceAttributeMultiprocessorCount, dev);
        if (hipFuncSetAttribute((const void*)mega_kernel, hipFuncAttributeMaxDynamicSharedMemorySize, LDS_BYTES) != hipSuccess) { fprintf(stderr, "hipFuncSetAttribute failed\n"); grid = -1; return; }
        if (hipOccupancyMaxActiveBlocksPerMultiprocessor(&per_cu, (const void*)mega_kernel, 512, LDS_BYTES) != hipSuccess || per_cu < 1) { fprintf(stderr, "occupancy query: %d\n", per_cu); per_cu = 1; }
        (void)hipGetLastError();
        grid = cus * 1;
    }
    if (grid < 0) return;
    Params p{};
    for (int i = 0; i < 36; ++i) p.in[i] = (const float*)d_in[i];
    p.out = (float*)d_out; p.ws = (unsigned char*)d_ws;
#if N_LAUNCH_MODE == 1
    for (int ph = 0; ph < NPHASE; ++ph) {
        p.ph_lo = ph; p.ph_hi = ph + 1;
        hipLaunchKernelGGL(mega_kernel, dim3(grid), dim3(512), LDS_BYTES, stream, p);
    }
#else
    p.ph_lo = 0; p.ph_hi = NPHASE;
    if (hipMemsetAsync((unsigned char*)d_ws + OFF_BAR, 0, XCD_BAR_WORDS * 4, stream) != hipSuccess) { fprintf(stderr, "memset failed\n"); return; }
    void* args[] = {&p};
    hipError_t e = hipLaunchCooperativeKernel((const void*)mega_kernel, dim3(grid), dim3(512), args, LDS_BYTES, stream);
    if (e != hipSuccess) fprintf(stderr, "cooperative launch failed: %s (grid %d)\n", hipGetErrorString(e), grid);
#endif
}
```

```cpp
#include <hip/hip_runtime.h>
#include <hip/hip_cooperative_groups.h>
#include <cstdio>
#include <cstdint>
namespace cg = cooperative_groups;

#define LAS __attribute__((address_space(3)))
typedef unsigned short bf16_t;
typedef short bf16x8 __attribute__((ext_vector_type(8)));
typedef float f32x4 __attribute__((ext_vector_type(4)));
typedef float f32x2 __attribute__((ext_vector_type(2)));
typedef unsigned u32x4 __attribute__((ext_vector_type(4)));
typedef unsigned u32x2 __attribute__((ext_vector_type(2)));

constexpr int T_ALL = 18432, T_LAT = 16384, DM = 1024, FF = 2816, SEQ = 2048, CTXL = 256, NB = 8;
constexpr int LDS_MAIN = 131072;
constexpr int LDS_BYTES = LDS_MAIN + 16;
constexpr int NPHASE = 26;
#define REPEAT_MASK 0u
constexpr size_t OFF_XS = 0;
constexpr size_t OFF_Y = OFF_XS + 8388608;
constexpr size_t OFF_H = OFF_Y + 37748736;
constexpr size_t OFF_BIG = OFF_H + 37748736;
constexpr size_t OFF_W = OFF_BIG + 113246208;
constexpr size_t OFF_MOD = OFF_W + 42991616;
constexpr size_t OFF_EXTRA = OFF_MOD + 663552;
constexpr size_t OFF_SP8 = OFF_EXTRA + 75497472;
constexpr size_t OFF_BAR = OFF_SP8 + 8192;
constexpr size_t WS_END = OFF_BAR + 16384;
constexpr size_t W_13_0 = 0, W_2_0 = 5767168, W_13_1 = 8650752, W_2_1 = 14417920, W_MIX = 17301504;
constexpr size_t W_HYIN = W_MIX, W_HYOUT = W_MIX + 3145728;
constexpr size_t W_RGIN = W_MIX, W_GATE = W_MIX + 2097152, W_RGOUT = W_MIX + 3145728;
constexpr size_t OFF_FILT = OFF_EXTRA;
constexpr size_t OFF_FILTC = OFF_EXTRA + 8388608;
constexpr size_t OFF_YP = OFF_EXTRA + 16777216;

#define PARG const __attribute__((address_space(4))) Params&
struct Params { const float* in[36]; float* out; unsigned char* ws; int ph_lo, ph_hi; };

__device__ __forceinline__ float bf2f(unsigned v) { return __uint_as_float(v << 16); }
__device__ __forceinline__ unsigned f2bf(float f) { unsigned u = __float_as_uint(f); u += 0x7FFFu + ((u >> 16) & 1u); return u >> 16; }
__device__ __forceinline__ unsigned pack2(float lo, float hi) { return f2bf(lo) | (f2bf(hi) << 16); }
__device__ __forceinline__ unsigned cvt_pk_bf16(float lo, float hi) { unsigned r; asm volatile("v_cvt_pk_bf16_f32 %0, %1, %2" : "=v"(r) : "v"(lo), "v"(hi)); return r; }
__device__ __forceinline__ float sigmoidf_(float x) { return 1.0f / (1.0f + __expf(-x)); }
__device__ __forceinline__ float siluf_(float x) { return x / (1.0f + __expf(-x)); }
__device__ __forceinline__ float geluf_(float x) { const float u = 0.7978845608f * (x + 0.044715f * x * x * x); const float e = __expf(2.0f * u); const float t = 1.0f - 2.0f / (e + 1.0f); return 0.5f * x * (1.0f + t); }
__device__ __forceinline__ float wave_sum(float v) {
#pragma unroll
    for (int o = 32; o > 0; o >>= 1) v += __shfl_xor(v, o, 64);
    return v;
}

namespace pg8 {
constexpr int BM = 256, BK = 64, HALF = 128, HTB = HALF * BK * 2, NXCD = 8, WGM = 8;
__host__ __device__ __forceinline__ int lds_byte(int r, int c) { const int st = (r >> 4) * 2 + (c >> 5), rr = r & 15, cc = c & 31, ob = rr * 64 + cc * 2; return st * 1024 + (ob ^ (((ob >> 9) & 1) << 5)); }
__host__ __device__ __forceinline__ void stage_rc(int b, int& R, int& C) { const int st = b / 1024, sb = b % 1024, swz = sb ^ (((sb >> 9) & 1) << 5); R = (st >> 1) * 16 + swz / 64; C = (st & 1) * 32 + (swz % 64) / 2; }
__host__ __device__ __forceinline__ int perm32(int rho) { const int n = rho >> 4, i = rho & 15; return 8 * (i >> 2) + 4 * n + (i & 3); }
struct Unit { int pm, pn, ks, nt, koff; };
struct Gemm { const bf16_t* A; const bf16_t* Bt; int M, N, K, lda, ldb, agrp, agoff; };
struct StaticOrder {
    int nM, nN, nwg, G, c, nctx, KS, ntt;
    __device__ void init(int M_main, int N, int K, int G_, int c_, int ctx_panels, int ks_) { nM = M_main / BM; nN = N / BM; nwg = nM * nN; G = G_; c = c_; nctx = ctx_panels; KS = ks_; ntt = K / BK; }
    __device__ bool next(int i, Unit& u) const {
        const long L = (long)i * G + c;
        if (L >= nwg) {
            int e = (int)(L - nwg); if (e >= nctx * nN * KS) return false;
            u.ks = e % KS; e /= KS; u.pn = e % nN; u.pm = 64 + e / nN; u.nt = ntt / KS; u.koff = u.ks * u.nt * BK; return true;
        }
        int wgid = (int)L; { const int q = nwg / NXCD, r = nwg % NXCD, xcd = wgid % NXCD, off = wgid / NXCD; wgid = (xcd < r ? xcd * (q + 1) : r * (q + 1) + (xcd - r) * q) + off; }
        const int nig = WGM * nN, gid = wgid / nig, fm = gid * WGM, gsz = (nM - fm) < WGM ? (nM - fm) : WGM;
        u.pm = fm + ((wgid % nig) % gsz); u.pn = (wgid % nig) / gsz; u.ks = 0; u.nt = ntt; u.koff = 0; return true;
    }
};

template <class Epi>
__device__ __forceinline__ void gemm_phase(LAS unsigned char* lds, const Gemm g, const StaticOrder& S, const Epi& E) {
    const int tid = threadIdx.x, wid = __builtin_amdgcn_readfirstlane(tid >> 6), lane = tid & 63, wr = wid >> 2, wc = wid & 3, fr = lane & 15, fq = lane >> 4;
    unsigned voffA[2], voffB[2];
#pragma unroll
    for (int i = 0; i < 2; ++i) { int R, C; stage_rc(tid * 16 + i * 8192, R, C); const int Rb = Epi::PERM ? ((R & ~31) + perm32(R & 31)) : R;
        voffA[i] = (unsigned)(R * g.lda + C) * 2u; voffB[i] = (unsigned)(Rb * g.ldb + C) * 2u; }
    const size_t kstep = (size_t)(BK * 2);
    const size_t hstepA = (size_t)HALF * g.lda * 2, hstepB = (size_t)HALF * g.ldb * 2;
    const size_t tstepA = 2 * hstepA, tstepB = 2 * hstepB;
    const unsigned ldsw = (unsigned)wid * 1024u;
    const int aoff = lds_byte(wr * 64 + fr, fq * 8), boff = lds_byte(wc * 32 + fr, fq * 8);
#define PG8_SA(b, h) (((b) * 2 + (h)) * HTB)
#define PG8_SB(b, h) ((4 + (b) * 2 + (h)) * HTB)
#define PG8_STAGE(bufoff, gbase, voff) do { _Pragma("unroll") for (int _i = 0; _i < 2; ++_i) \
        __builtin_amdgcn_global_load_lds((const unsigned*)((const char*)(gbase) + (voff)[_i]), (LAS unsigned*)(lds + (bufoff) + ldsw + _i * 8192), 16, 0, 0); } while (0)
#define PG8_LDA(dst, b, h) do { _Pragma("unroll") for (int m = 0; m < 4; ++m) _Pragma("unroll") for (int k = 0; k < 2; ++k) dst[m][k] = *(const LAS bf16x8*)(lds + PG8_SA(b, h) + aoff + m * 2048 + k * 1024); } while (0)
#define PG8_LDB(dst, b, h) do { _Pragma("unroll") for (int n = 0; n < 2; ++n) _Pragma("unroll") for (int k = 0; k < 2; ++k) dst[n][k] = *(const LAS bf16x8*)(lds + PG8_SB(b, h) + boff + n * 2048 + k * 1024); } while (0)
#define PG8_MMA(ai, bj, At, Bt) do { __builtin_amdgcn_s_setprio(1); _Pragma("unroll") for (int m = 0; m < 4; ++m) _Pragma("unroll") for (int n = 0; n < 2; ++n) _Pragma("unroll") for (int k = 0; k < 2; ++k) \
        acc[ai][bj][m][n] = __builtin_amdgcn_mfma_f32_16x16x32_bf16(Bt[n][k], At[m][k], acc[ai][bj][m][n], 0, 0, 0); __builtin_amdgcn_s_setprio(0); } while (0)
#define PG8_WAIT_V(n) asm volatile("s_waitcnt vmcnt(" #n ")" ::: "memory")
#define PG8_WAIT_L(n) asm volatile("s_waitcnt lgkmcnt(" #n ")" ::: "memory")
#define PG8_BAR __builtin_amdgcn_s_barrier()
#define PG8_SCHED __builtin_amdgcn_sched_barrier(0)
#define PG8_UA(u) ((const char*)g.A + (size_t)(u).pm * tstepA + (size_t)((u).pn / g.agrp) * (size_t)g.agoff * 2 + (size_t)(u).koff * 2)
#define PG8_UB(u) ((const char*)g.Bt + (size_t)(u).pn * tstepB + (size_t)(u).koff * 2)
    Unit cur, nxt; int ui = 0;
    if (!S.next(0, cur)) return;
    f32x4 acc[2][2][4][2];
#pragma unroll
    for (int a = 0; a < 2; ++a)
#pragma unroll
        for (int b = 0; b < 2; ++b)
#pragma unroll
            for (int m = 0; m < 4; ++m)
#pragma unroll
                for (int n = 0; n < 2; ++n) acc[a][b][m][n] = (f32x4){0.f, 0.f, 0.f, 0.f};
    bf16x8 At[4][2], B0[2][2], B1[2][2];
    const char* cA = PG8_UA(cur); const char* cB = PG8_UB(cur);
    PG8_STAGE(PG8_SB(0, 0), cB, voffB); PG8_STAGE(PG8_SA(0, 0), cA, voffA); PG8_STAGE(PG8_SB(0, 1), cB + hstepB, voffB); PG8_STAGE(PG8_SA(0, 1), cA + hstepA, voffA);
    if (wr == 1) PG8_BAR;
    PG8_WAIT_V(4); PG8_BAR;
    PG8_STAGE(PG8_SB(1, 0), cB + kstep, voffB); PG8_STAGE(PG8_SA(1, 0), cA + kstep, voffA); PG8_STAGE(PG8_SB(1, 1), cB + hstepB + kstep, voffB);
    PG8_WAIT_V(6); PG8_BAR;
    for (;;) {
        const bool has_next = S.next(ui + 1, nxt);
        const char* nA = has_next ? PG8_UA(nxt) : cA; const char* nB = has_next ? PG8_UB(nxt) : cB;
        const int nt = cur.nt;
        for (int t = 0; t < nt; t += 2) {
            const bool last = (t == nt - 2);
            const char* a1 = cA + (size_t)(t + 1) * kstep;
            const char* a2 = last ? nA : cA + (size_t)(t + 2) * kstep; const char* b2 = last ? nB : cB + (size_t)(t + 2) * kstep;
            const char* a3 = a2 + kstep; const char* b3 = b2 + kstep;
            PG8_LDB(B0, 0, 0); PG8_SCHED; PG8_LDA(At, 0, 0); PG8_STAGE(PG8_SA(1, 1), a1 + hstepA, voffA);
            PG8_WAIT_L(8); PG8_BAR; PG8_WAIT_L(0); PG8_MMA(0, 0, At, B0); PG8_BAR; PG8_SCHED;
            PG8_LDB(B1, 0, 1); PG8_STAGE(PG8_SB(0, 0), b2, voffB);
            PG8_BAR; PG8_WAIT_L(0); PG8_MMA(0, 1, At, B1); PG8_BAR;
            PG8_LDA(At, 0, 1); PG8_STAGE(PG8_SA(0, 0), a2, voffA);
            PG8_BAR; PG8_WAIT_L(0); PG8_MMA(1, 0, At, B0); PG8_BAR; PG8_SCHED;
            PG8_STAGE(PG8_SB(0, 1), b2 + hstepB, voffB);
            PG8_WAIT_V(6); PG8_BAR; PG8_MMA(1, 1, At, B1); PG8_BAR;
            PG8_LDB(B0, 1, 0); PG8_SCHED; PG8_LDA(At, 1, 0); PG8_STAGE(PG8_SA(0, 1), a2 + hstepA, voffA);
            PG8_WAIT_L(8); PG8_BAR; PG8_WAIT_L(0); PG8_MMA(0, 0, At, B0); PG8_BAR; PG8_SCHED;
            PG8_LDB(B1, 1, 1); PG8_STAGE(PG8_SB(1, 0), b3, voffB);
            PG8_BAR; PG8_WAIT_L(0); PG8_MMA(0, 1, At, B1); PG8_BAR;
            PG8_LDA(At, 1, 1); PG8_STAGE(PG8_SA(1, 0), a3, voffA);
            PG8_BAR; PG8_WAIT_L(0); PG8_MMA(1, 0, At, B0); PG8_BAR; PG8_SCHED;
            PG8_STAGE(PG8_SB(1, 1), b3 + hstepB, voffB);
            PG8_WAIT_V(6); PG8_BAR; PG8_MMA(1, 1, At, B1); PG8_BAR;
        }
        E(acc, cur, wr, wc, fr, fq);
        if (!has_next) break;
#pragma unroll
        for (int a = 0; a < 2; ++a)
#pragma unroll
            for (int b = 0; b < 2; ++b)
#pragma unroll
                for (int m = 0; m < 4; ++m)
#pragma unroll
                    for (int n = 0; n < 2; ++n) acc[a][b][m][n] = (f32x4){0.f, 0.f, 0.f, 0.f};
        cur = nxt; cA = nA; cB = nB; ++ui;
    }
    PG8_WAIT_V(0);
    if (wr == 0) PG8_BAR;
    PG8_BAR;
#undef PG8_SA
#undef PG8_SB
#undef PG8_STAGE
#undef PG8_LDA
#undef PG8_LDB
#undef PG8_MMA
#undef PG8_WAIT_V
#undef PG8_WAIT_L
#undef PG8_BAR
#undef PG8_SCHED
#undef PG8_UA
#undef PG8_UB
}

struct EpiSwiglu {
    static constexpr bool PERM = true;
    bf16_t* O;
    __device__ __forceinline__ void operator()(const f32x4 (&acc)[2][2][4][2], const Unit& u, int wr, int wc, int fr, int fq) const {
        const int row0 = u.pm * BM + wr * 64 + fr, col0 = u.pn * 128 + wc * 32 + 8 * fq;
#pragma unroll
        for (int ai = 0; ai < 2; ++ai)
#pragma unroll
            for (int m = 0; m < 4; ++m) {
                bf16_t* rowp = O + (size_t)(row0 + ai * HALF + m * 16) * FF + col0;
                float v[8];
#pragma unroll
                for (int n = 0; n < 2; ++n)
#pragma unroll
                    for (int j = 0; j < 4; ++j) v[n * 4 + j] = siluf_(acc[ai][0][m][n][j]) * acc[ai][1][m][n][j];
                u32x4 w; w.x = cvt_pk_bf16(v[0], v[1]); w.y = cvt_pk_bf16(v[2], v[3]); w.z = cvt_pk_bf16(v[4], v[5]); w.w = cvt_pk_bf16(v[6], v[7]);
                *(u32x4*)rowp = w;
            }
    }
};
struct EpiBf16 {
    static constexpr bool PERM = true;
    bf16_t* O; int ldc; const float* cbias; const float* rbias; int split_cols; size_t split_stride; bf16_t* P;
    __device__ __forceinline__ void operator()(const f32x4 (&acc)[2][2][4][2], const Unit& u, int wr, int wc, int fr, int fq) const {
        const int row0 = u.pm * BM + wr * 64 + fr; int colt = u.pn * BM; bf16_t* base = O;
        const bool part = u.ks > 0;
        if (part) base = P + (size_t)(u.ks - 1) * (2048 * DM) - (size_t)T_LAT * ldc;
        if (split_cols) { const int t = colt / split_cols; base += (size_t)t * split_stride; colt -= t * split_cols; }
        const int col0 = colt + wc * 32 + 8 * fq, bcol0 = u.pn * BM + wc * 32 + 8 * fq;
        f32x4 bv[2][2];
#pragma unroll
        for (int bj = 0; bj < 2; ++bj)
#pragma unroll
            for (int n = 0; n < 2; ++n) bv[bj][n] = (cbias && !part) ? *(const f32x4*)(cbias + bcol0 + bj * HALF + 4 * n) : (f32x4){0.f, 0.f, 0.f, 0.f};
#pragma unroll
        for (int ai = 0; ai < 2; ++ai)
#pragma unroll
            for (int m = 0; m < 4; ++m) {
                const int row = row0 + ai * HALF + m * 16;
                const float rb = rbias ? rbias[row] : 0.f;
                bf16_t* rowp = base + (size_t)row * ldc + col0;
#pragma unroll
                for (int bj = 0; bj < 2; ++bj) { f32x4 v0 = acc[ai][bj][m][0] + bv[bj][0] + rb, v1 = acc[ai][bj][m][1] + bv[bj][1] + rb;
                    u32x4 w; w.x = cvt_pk_bf16(v0[0], v0[1]); w.y = cvt_pk_bf16(v0[2], v0[3]); w.z = cvt_pk_bf16(v1[0], v1[1]); w.w = cvt_pk_bf16(v1[2], v1[3]);
                    *(u32x4*)(rowp + bj * HALF) = w; }
            }
    }
};
struct EpiGate {
    static constexpr bool PERM = false;
    unsigned* GA0; unsigned* GA1; const bf16_t* XC; const float* ba; const float* bi; const float* lam;
    __device__ __forceinline__ void operator()(const f32x4 (&acc)[2][2][4][2], const Unit& u, int wr, int wc, int fr, int fq) const {
        const int row0 = u.pm * BM + wr * 64 + fr;
        const int ch0 = (u.pn >> 2) * 256 + (u.pn & 3) * 64 + wc * 16 + fq * 4;
#pragma unroll
        for (int d = 0; d < 2; ++d) {
            unsigned* GA = d ? GA1 : GA0;
#pragma unroll
            for (int ai = 0; ai < 2; ++ai)
#pragma unroll
                for (int m = 0; m < 4; ++m) {
                    const int row = row0 + ai * HALF + m * 16;
                    const f32x4 bav = *(const f32x4*)(ba + d * DM + ch0), biv = *(const f32x4*)(bi + d * DM + ch0), spv = *(const f32x4*)(lam + d * DM + ch0);
                    const u32x2 xr = *(const u32x2*)(XC + (size_t)row * DM + ch0);
                    const float xc[4] = {bf2f(xr.x & 0xffffu), bf2f(xr.x >> 16), bf2f(xr.y & 0xffffu), bf2f(xr.y >> 16)};
                    u32x4 w;
#pragma unroll
                    for (int j = 0; j < 4; ++j) {
                        const float rr = sigmoidf_(acc[ai][d][m][0][j] + bav[j]);
                        const float ii = sigmoidf_(acc[ai][d][m][1][j] + biv[j]);
                        const float la = rr * spv[j];
                        const float bb = sqrtf(fmaxf(1.0f - __expf(2.0f * la), 0.f)) * ii * xc[j];
                        w[j] = cvt_pk_bf16(la, bb);
                    }
                    *(u32x4*)(GA + (size_t)row * DM + ch0) = w;
                    asm volatile("" ::: "memory");
                }
        }
    }
};
}

__device__ __forceinline__ void convT_tile(LAS unsigned char* lds, const float* src, int N, int K, bf16_t* dst, int mode, int aux, int tile) {
    LAS float* t = (LAS float*)lds;
    const int ntn = N / 256, tk = tile / ntn, tn = tile % ntn, k0 = tk * 64, n0 = tn * 256, tid = threadIdx.x;
    {
        const int kk = tid >> 6, n4 = (tid & 63) * 4;
        f32x4 v[8];
#pragma unroll
        for (int i = 0; i < 8; ++i) v[i] = *(const f32x4*)(src + (size_t)(k0 + kk + 8 * i) * N + n0 + n4);
#pragma unroll
        for (int i = 0; i < 8; ++i)
#pragma unroll
            for (int j = 0; j < 4; ++j) t[(kk + 8 * i) * 257 + n4 + j] = v[i][j];
    }
    __syncthreads();
#pragma unroll
    for (int i = 0; i < 4; ++i) {
        const int pi = tid + 512 * i, n = pi >> 3, k8 = (pi & 7) * 8, ng = n0 + n;
        int row;
        if (mode == 0) row = ng;
        else if (mode == 1) row = (ng >> 7) * 256 + (ng & 127);
        else if (mode == 2) row = (ng >> 7) * 256 + 128 + (ng & 127);
        else { const int d = aux & 1, gate = (aux >> 1) & 1, h = aux >> 2; const int pn = 4 * h + (ng >> 6), q = ng & 63;
               row = 256 * pn + 128 * d + 32 * (q >> 4) + 16 * gate + (q & 15); }
        float v[8];
#pragma unroll
        for (int j = 0; j < 8; ++j) v[j] = t[(k8 + j) * 257 + n];
        u32x4 w; w.x = pack2(v[0], v[1]); w.y = pack2(v[2], v[3]); w.z = pack2(v[4], v[5]); w.w = pack2(v[6], v[7]);
        *(u32x4*)(dst + (size_t)row * K + k0 + k8) = w;
    }
    __syncthreads();
}

__device__ __forceinline__ int conv_items(PARG p, LAS unsigned char* lds, int layer, int tile) {
    bf16_t* W = (bf16_t*)(p.ws + OFF_W);
    int base = 0;
#define CONV_MAT(SRC, NN, KK, DST, MODE, AUX) { const int cnt = ((NN) / 256) * ((KK) / 64); if (tile >= base && tile < base + cnt) { convT_tile(lds, (SRC), (NN), (KK), (DST), (MODE), (AUX), tile - base); return -1; } base += cnt; }
    for (int s = 0; s < 2; ++s) {
        const size_t o = ((size_t)layer * 2 + s) * DM * FF;
        bf16_t* w13 = W + (s ? W_13_1 : W_13_0); bf16_t* w2 = W + (s ? W_2_1 : W_2_0);
        CONV_MAT(p.in[7] + o, FF, DM, w13, 1, 0)
        CONV_MAT(p.in[8] + o, FF, DM, w13, 2, 0)
        CONV_MAT(p.in[9] + o, DM, FF, w2, 0, 0)
    }
    if (layer == 0) {
        CONV_MAT(p.in[10], 3 * DM, DM, W + W_HYIN, 0, 0)
        CONV_MAT(p.in[23], DM, DM, W + W_HYOUT, 0, 0)
    } else {
        CONV_MAT(p.in[25], 2 * DM, DM, W + W_RGIN, 0, 0)
        CONV_MAT(p.in[34], DM, DM, W + W_RGOUT, 0, 0)
        for (int d = 0; d < 2; ++d) for (int h = 0; h < 4; ++h) {
            CONV_MAT(p.in[29] + ((size_t)d * 4 + h) * 65536, 256, 256, W + W_GATE, 3, d | (0 << 1) | (h << 2))
            CONV_MAT(p.in[31] + ((size_t)d * 4 + h) * 65536, 256, 256, W + W_GATE, 3, d | (1 << 1) | (h << 2))
        }
    }
#undef CONV_MAT
    return base;
}
__device__ __forceinline__ void convert_weights(PARG p, LAS unsigned char* lds, int layer) {
    const int total = conv_items(p, lds, layer, -1);
    for (int t = blockIdx.x; t < total; t += gridDim.x) conv_items(p, lds, layer, t);
}

__device__ __forceinline__ void ada_phase(PARG p, LAS unsigned char* lds) {
    LAS float* sc = (LAS float*)lds;
    LAS float* red = sc + 9 * 1024;
    const int tid = threadIdx.x;
    bool loaded = false;
    float* MOD = (float*)(p.ws + OFF_MOD);
    for (int item = blockIdx.x; item < 288; item += gridDim.x) {
        if (!loaded) {
            for (int i = tid; i < 9 * 1024; i += 512) { const float v = (i < 8192) ? p.in[1][i] : p.in[3][i - 8192]; sc[i] = siluf_(v); }
            __syncthreads(); loaded = true;
        }
        const int l = item / 144, n0 = (item % 144) * 64, kc = tid >> 6, col = tid & 63;
        const float* w = p.in[4] + (size_t)l * DM * 9216 + n0 + col;
        float a[9];
#pragma unroll
        for (int m = 0; m < 9; ++m) a[m] = 0.f;
#pragma unroll 1
        for (int k0 = kc * 128; k0 < kc * 128 + 128; k0 += 32) {
            float wv[32];
#pragma unroll
            for (int i = 0; i < 32; ++i) wv[i] = w[(size_t)(k0 + i) * 9216];
#pragma unroll
            for (int i = 0; i < 32; ++i)
#pragma unroll
                for (int m = 0; m < 9; ++m) a[m] += sc[m * 1024 + k0 + i] * wv[i];
        }
#pragma unroll
        for (int m = 0; m < 9; ++m) red[(kc * 9 + m) * 64 + col] = a[m];
        __syncthreads();
        for (int i = tid; i < 9 * 64; i += 512) {
            const int m = i >> 6, c2 = i & 63; float s = 0.f;
#pragma unroll
            for (int q = 0; q < 8; ++q) s += red[(q * 9 + m) * 64 + c2];
            MOD[((size_t)l * 9 + m) * 9216 + n0 + c2] = s + p.in[5][(size_t)l * 9216 + n0 + c2];
        }
        __syncthreads();
    }
    __syncthreads();
}

__device__ __forceinline__ void filter_item(PARG p, LAS unsigned char* lds, int L, int k0, bf16_t* FT, int ldq) {
    LAS float* zf = (LAS float*)lds;
    LAS float* hA = zf + 16 * 64;
    LAS float* hB = hA + 16 * 64;
    LAS float* W0 = hB + 16 * 64;
    LAS float* W1 = W0 + 33 * 64;
    LAS float* W2 = W1 + 64 * 64;
    const int tid = threadIdx.x, w = tid >> 6, lane = tid & 63;
    const float* fb0 = p.in[15]; const float* fb1 = p.in[17]; const float* fb2 = p.in[19]; const float* freq = p.in[20]; const float* fwout = p.in[21];
    for (int i = tid; i < 33 * 64; i += 512) W0[i] = p.in[14][i];
    for (int i = tid; i < 64 * 64; i += 512) { W1[i] = p.in[16][i]; W2[i] = p.in[18][i]; }
#pragma unroll 1
    for (int pp = 0; pp < 2; ++pp) {
        const int pi = w * 2 + pp, k = k0 + pi;
        float f = 0.f;
        if (lane == 0) f = (float)k / (float)(L - 1);
        else if (lane < 33) {
            const int band = (lane - 1) & 15;
            const float fr = 1e-4f + (float)band * ((15.0f - 1e-4f) / 15.0f);
            const float wk = 6.283185307179586f * (float)k / (float)L;
            const float ph = fr * wk;
            f = (lane <= 16) ? cosf(ph) : -sinf(ph);
        }
        zf[pi * 64 + lane] = f;
    }
    __syncthreads();
    {
        const float b0 = fb0[lane], f0 = freq[lane];
        float a0 = b0, a1 = b0;
#pragma unroll 11
        for (int e = 0; e < 33; ++e) { const float wv = W0[e * 64 + lane]; a0 += zf[(w * 2) * 64 + e] * wv; a1 += zf[(w * 2 + 1) * 64 + e] * wv; }
        hA[(w * 2) * 64 + lane] = sinf(f0 * a0); hA[(w * 2 + 1) * 64 + lane] = sinf(f0 * a1);
    }
    __syncthreads();
    {
        const float b0 = fb1[lane], f0 = freq[64 + lane];
        float a0 = b0, a1 = b0;
#pragma unroll 16
        for (int e = 0; e < 64; ++e) { const float wv = W1[e * 64 + lane]; a0 += hA[(w * 2) * 64 + e] * wv; a1 += hA[(w * 2 + 1) * 64 + e] * wv; }
        hB[(w * 2) * 64 + lane] = sinf(f0 * a0); hB[(w * 2 + 1) * 64 + lane] = sinf(f0 * a1);
    }
    __syncthreads();
    {
        const float b0 = fb2[lane], f0 = freq[128 + lane];
        float a0 = b0, a1 = b0;
#pragma unroll 16
        for (int e = 0; e < 64; ++e) { const float wv = W2[e * 64 + lane]; a0 += hB[(w * 2) * 64 + e] * wv; a1 += hB[(w * 2 + 1) * 64 + e] * wv; }
        __syncthreads();
        hA[(w * 2) * 64 + lane] = sinf(f0 * a0); hA[(w * 2 + 1) * 64 + lane] = sinf(f0 * a1);
    }
    __syncthreads();
    const float min_decay = -3.0701134573253945f, max_decay = -15.350567286626973f;
#pragma unroll 1
    for (int q = 0; q < 4; ++q) {
        const int n = tid + 512 * q;
        float acc[16];
#pragma unroll
        for (int i = 0; i < 16; ++i) acc[i] = 0.f;
#pragma unroll 1
        for (int e0 = 0; e0 < 64; e0 += 32) {
            float wv[32];
#pragma unroll
            for (int e = 0; e < 32; ++e) wv[e] = fwout[(e0 + e) * 2048 + n];
#pragma unroll
            for (int e = 0; e < 32; ++e)
#pragma unroll
                for (int i = 0; i < 16; ++i) acc[i] += hA[i * 64 + e0 + e] * wv[e];
        }
        const int c = n & 1023; const bool bwd = n >= 1024;
        const float delta = fabsf(min_decay + (float)c * ((max_decay - min_decay) / 1023.0f));
        bf16_t* dst = FT + (size_t)c * ldq;
#pragma unroll
        for (int i = 0; i < 16; ++i) {
            const int k = k0 + i;
            const float tk = (float)k / (float)(L - 1);
            const float val = acc[i] * __expf(-tk * delta);
            if (!bwd) dst[(L - 1) - k] = (bf16_t)f2bf(val);
            else if (k >= 1) dst[(L - 1) + k] = (bf16_t)f2bf(val);
        }
        if (k0 == 0 && !bwd) dst[2 * L - 1] = 0;
    }
    __syncthreads();
}
__device__ __forceinline__ void filter_phase(PARG p, LAS unsigned char* lds) {
    for (int item = (int)gridDim.x - 1 - (int)blockIdx.x; item < 144; item += gridDim.x) {
        if (item < 128) filter_item(p, lds, SEQ, item * 16, (bf16_t*)(p.ws + OFF_FILT), 4096);
        else filter_item(p, lds, CTXL, (item - 128) * 16, (bf16_t*)(p.ws + OFF_FILTC), 512);
    }
}

struct EwArgs { int init; int has_h; int nrows; float coef; int lres, gate_i, gpost_i; int lh, gpre_i, shift_i, scale_i; int nks; };
__device__ __forceinline__ float* xrow_ptr(PARG p, int row) { return row < T_LAT ? p.out + (size_t)row * DM : (float*)(p.ws + OFF_XS) + (size_t)(row - T_LAT) * DM; }
__device__ __forceinline__ void ew_phase(PARG p, const EwArgs a) {
    const int lane = threadIdx.x & 63, wv = threadIdx.x >> 6;
    const float* MOD = (const float*)(p.ws + OFF_MOD);
    const float* NG = p.in[6];
    const bf16_t* Y = (const bf16_t*)(p.ws + OFF_Y);
    bf16_t* H = (bf16_t*)(p.ws + OFF_H);
    for (int row = blockIdx.x * 8 + wv; row < a.nrows; row += gridDim.x * 8) {
        const int midx = row < T_LAT ? (row >> 11) : 8;
        float* xp = xrow_ptr(p, row);
        f32x4 x[4], g[4], sh[4], scl[4];
        if (a.has_h) {
#pragma unroll
            for (int q = 0; q < 4; ++q) {
                const int col = q * 256 + lane * 4;
                g[q] = *(const f32x4*)(NG + ((size_t)a.lh * 6 + a.gpre_i) * DM + col);
                sh[q] = *(const f32x4*)(MOD + ((size_t)a.lh * 9 + midx) * 9216 + a.shift_i * DM + col);
                scl[q] = *(const f32x4*)(MOD + ((size_t)a.lh * 9 + midx) * 9216 + a.scale_i * DM + col);
            }
        }
        if (a.init) {
            if (row < T_LAT) {
                const int t = row & (SEQ - 1); const float pr = (float)(t >> 6), pc = (float)(t & 63);
#pragma unroll
                for (int q = 0; q < 4; ++q) {
                    const int col = q * 256 + lane * 4;
                    f32x4 v = *(const f32x4*)(p.in[0] + (size_t)row * DM + col);
#pragma unroll
                    for (int j = 0; j < 4; ++j) {
                        const int d = col + j, i = d & 255;
                        const float om = __expf(-(float)i * (9.210340371976184f / 256.0f));
                        const float ang = ((d < 512) ? pr : pc) * om;
                        v[j] += ((d >> 8) & 1) ? cosf(ang) : sinf(ang);
                    }
                    x[q] = v;
                }
            } else {
#pragma unroll
                for (int q = 0; q < 4; ++q) x[q] = *(const f32x4*)(p.in[2] + (size_t)(row - T_LAT) * DM + q * 256 + lane * 4);
            }
        } else {
            f32x4 y[4], gt[4], gp[4]; u32x2 yr[4]; float ss = 0.f;
#pragma unroll
            for (int q = 0; q < 4; ++q) {
                const int col = q * 256 + lane * 4;
                x[q] = *(const f32x4*)(xp + col);
                yr[q] = *(const u32x2*)(Y + (size_t)row * DM + col);
                gt[q] = *(const f32x4*)(MOD + ((size_t)a.lres * 9 + midx) * 9216 + a.gate_i * DM + col);
                gp[q] = *(const f32x4*)(NG + ((size_t)a.lres * 6 + a.gpost_i) * DM + col);
            }
#pragma unroll
            for (int q = 0; q < 4; ++q) {
                y[q] = (f32x4){bf2f(yr[q].x & 0xffffu), bf2f(yr[q].x >> 16), bf2f(yr[q].y & 0xffffu), bf2f(yr[q].y >> 16)};
                if (row >= T_LAT) for (int k = 0; k + 1 < a.nks; ++k) {
                    const u32x2 pr2 = *(const u32x2*)((const bf16_t*)(p.ws + OFF_YP) + ((size_t)k * 2048 + (row - T_LAT)) * DM + q * 256 + lane * 4);
                    y[q] = y[q] + (f32x4){bf2f(pr2.x & 0xffffu), bf2f(pr2.x >> 16), bf2f(pr2.y & 0xffffu), bf2f(pr2.y >> 16)};
                }
#pragma unroll
                for (int j = 0; j < 4; ++j) ss += y[q][j] * y[q][j];
            }
            ss = wave_sum(ss);
            const float r = a.coef * rsqrtf(ss * (1.0f / DM) + 1e-6f);
#pragma unroll
            for (int q = 0; q < 4; ++q) x[q] = x[q] + (r * gt[q]) * (y[q] * gp[q]);
        }
#pragma unroll
        for (int q = 0; q < 4; ++q) *(f32x4*)(xp + q * 256 + lane * 4) = x[q];
        if (a.has_h) {
            float ss = 0.f;
#pragma unroll
            for (int q = 0; q < 4; ++q)
#pragma unroll
                for (int j = 0; j < 4; ++j) ss += x[q][j] * x[q][j];
            ss = wave_sum(ss);
            const float r = rsqrtf(ss * (1.0f / DM) + 1e-6f);
#pragma unroll
            for (int q = 0; q < 4; ++q) {
                const int col = q * 256 + lane * 4;
                const f32x4 h = (x[q] * r) * g[q] * (scl[q] + 1.0f) + sh[q];
                u32x2 w; w.x = pack2(h[0], h[1]); w.y = pack2(h[2], h[3]);
                *(u32x2*)(H + (size_t)row * DM + col) = w;
            }
        }
    }
}

template <int L>
__device__ __forceinline__ void longconv_channel(PARG p, LAS unsigned char* lds, int c) {
    constexpr int NBLK = L / 64, NCOL = NBLK * 8, FLEN = 2 * L, CSTRIDE = FLEN * 2 + 32, ZSTRIDE = 144;
    constexpr int Z_OFF = 8 * CSTRIDE;
    constexpr int MB = (L == SEQ) ? 4 : 1, CBW = (L == SEQ) ? 2 : 1;
    static_assert(Z_OFF + NCOL * ZSTRIDE <= LDS_MAIN, "lds");
    const int tid = threadIdx.x, wid = tid >> 6, lane = tid & 63, fr = lane & 15, fq = lane >> 4;
    const int tok0 = (L == SEQ) ? 0 : T_LAT;
    const bf16_t* UT = (const bf16_t*)(p.ws + OFF_BIG);
    const bf16_t* FT = (L == SEQ) ? (const bf16_t*)(p.ws + OFF_FILT) + (size_t)c * 4096 : (const bf16_t*)(p.ws + OFF_FILTC) + (size_t)c * 512;
    bf16_t* YT = (bf16_t*)(p.ws + OFF_Y);
    const float* cw = p.in[12]; const float* cb = p.in[13];
    for (int v = tid; v < FLEN / 8; v += 512) *(LAS u32x4*)(lds + v * 16) = *(const u32x4*)(FT + v * 8);
    {
        const float w10 = cw[0 * 3072 + 1024 + c], w11 = cw[1 * 3072 + 1024 + c], w12 = cw[2 * 3072 + 1024 + c], b1 = cb[1024 + c];
        const float w20 = cw[0 * 3072 + 2048 + c], w21 = cw[1 * 3072 + 2048 + c], w22 = cw[2 * 3072 + 2048 + c], b2 = cb[2048 + c];
        const bf16_t* r1 = UT + (size_t)(1024 + c) * T_ALL + tok0; const bf16_t* r2 = UT + (size_t)(2048 + c) * T_ALL + tok0;
        for (int g = tid; g < NB * L / 8; g += 512) {
            const int b = g / (L / 8), t0 = (g % (L / 8)) * 8;
            const size_t o = (size_t)b * L + t0;
            const u32x4 a = *(const u32x4*)(r1 + o); const u32x4 bq = *(const u32x4*)(r2 + o);
            float x1[10], x2[10];
            x1[0] = t0 > 0 ? bf2f(r1[o - 1]) : 0.f; x2[0] = t0 > 0 ? bf2f(r2[o - 1]) : 0.f;
            x1[9] = t0 + 8 < L ? bf2f(r1[o + 8]) : 0.f; x2[9] = t0 + 8 < L ? bf2f(r2[o + 8]) : 0.f;
#pragma unroll
            for (int j = 0; j < 4; ++j) { x1[1 + 2 * j] = bf2f(a[j] & 0xffffu); x1[2 + 2 * j] = bf2f(a[j] >> 16); x2[1 + 2 * j] = bf2f(bq[j] & 0xffffu); x2[2 + 2 * j] = bf2f(bq[j] >> 16); }
            float z[8];
#pragma unroll
            for (int j = 0; j < 8; ++j) z[j] = (b1 + w10 * x1[j] + w11 * x1[j + 1] + w12 * x1[j + 2]) * (b2 + w20 * x2[j] + w21 * x2[j + 1] + w22 * x2[j + 2]);
            u32x4 w; w.x = pack2(z[0], z[1]); w.y = pack2(z[2], z[3]); w.z = pack2(z[4], z[5]); w.w = pack2(z[6], z[7]);
            *(LAS u32x4*)(lds + Z_OFF + ((t0 >> 6) * 8 + b) * ZSTRIDE + (t0 & 63) * 2) = w;
        }
    }
    __syncthreads();
    {
        const LAS unsigned* D = (const LAS unsigned*)lds;
        for (int v = tid; v < FLEN / 8; v += 512) {
            unsigned d[8];
#pragma unroll
            for (int i = 0; i < 8; ++i) d[i] = D[4 * v + i];
#pragma unroll
            for (int j = 1; j < 8; ++j) {
                u32x4 w;
#pragma unroll
                for (int i = 0; i < 4; ++i) w[i] = (j & 1) ? __builtin_amdgcn_alignbyte(d[i + (j + 1) / 2], d[i + (j - 1) / 2], 2) : d[i + j / 2];
                *(LAS u32x4*)(lds + j * CSTRIDE + v * 16) = w;
            }
        }
    }
    __syncthreads();
    const int mb0 = (L == SEQ) ? 0 : (wid & 3), cb0 = (L == SEQ) ? 2 * wid : (wid >> 2);
    f32x4 acc[CBW][MB];
#pragma unroll
    for (int x = 0; x < CBW; ++x)
#pragma unroll
        for (int m = 0; m < MB; ++m) acc[x][m] = (f32x4){0.f, 0.f, 0.f, 0.f};
    const int jj = (7 - fr) & 7;
    const int abase = jj * CSTRIDE + 2 * ((L - 1) - fr - jj + 8 * fq);
    const int ilo = 2 * cb0, ihi = 2 * (cb0 + CBW) - 1;
    if constexpr (L == SEQ) {
        const int col = 16 * cb0 + fr, ib = col >> 3;
        auto getB = [&](int dd, bf16x8 (&o)[2]) {
            const int ip = ib - dd; const bool ok = (ip >= 0) && (ip < NBLK); const int colp = ok ? col - 8 * dd : col;
#pragma unroll
            for (int k = 0; k < 2; ++k) { bf16x8 v = *(const LAS bf16x8*)(lds + Z_OFF + colp * ZSTRIDE + (32 * k + 8 * fq) * 2); if (!ok) v = (bf16x8){0, 0, 0, 0, 0, 0, 0, 0}; o[k] = v; }
        };
        const int d0 = ilo - (NBLK - 1);
        bf16x8 F[6], h0[2], h1[2], bn[2];
        getB(d0 - 2, h0); getB(d0 - 1, h1);
        F[4] = *(const LAS bf16x8*)(lds + abase - 32 * (4 * d0 - 2)); F[5] = *(const LAS bf16x8*)(lds + abase - 32 * (4 * d0 - 1));
#pragma unroll 2
        for (int d = d0; d <= ihi; ++d) {
            F[0] = F[4]; F[1] = F[5];
#pragma unroll
            for (int i = 2; i < 6; ++i) F[i] = *(const LAS bf16x8*)(lds + abase - 32 * (4 * d - 2 + i));
            getB(d, bn);
#pragma unroll
            for (int m = 0; m < 4; ++m) {
                acc[0][m] = __builtin_amdgcn_mfma_f32_16x16x32_bf16(F[m + 2], bn[0], acc[0][m], 0, 0, 0);
                acc[0][m] = __builtin_amdgcn_mfma_f32_16x16x32_bf16(F[m], bn[1], acc[0][m], 0, 0, 0);
                acc[1][m] = __builtin_amdgcn_mfma_f32_16x16x32_bf16(F[m + 2], h0[0], acc[1][m], 0, 0, 0);
                acc[1][m] = __builtin_amdgcn_mfma_f32_16x16x32_bf16(F[m], h0[1], acc[1][m], 0, 0, 0);
            }
            h0[0] = h1[0]; h0[1] = h1[1]; h1[0] = bn[0]; h1[1] = bn[1];
        }
    } else {
    for (int d = ilo - (NBLK - 1); d <= ihi; ++d) {
        bf16x8 af[MB][2];
#pragma unroll
        for (int m = 0; m < MB; ++m)
#pragma unroll
            for (int k = 0; k < 2; ++k) af[m][k] = *(const LAS bf16x8*)(lds + abase + 2 * (-64 * d - 16 * (mb0 + m) + 32 * k));
#pragma unroll
        for (int x = 0; x < CBW; ++x) {
            const int col = 16 * (cb0 + x) + fr, ip = (col >> 3) - d;
            const bool ok = (ip >= 0) && (ip < NBLK);
            const int colp = ok ? col - 8 * d : col;
            bf16x8 bfr[2];
#pragma unroll
            for (int k = 0; k < 2; ++k) {
                bf16x8 v = *(const LAS bf16x8*)(lds + Z_OFF + colp * ZSTRIDE + (32 * k + 8 * fq) * 2);
                if (!ok) v = (bf16x8){0, 0, 0, 0, 0, 0, 0, 0};
                bfr[k] = v;
            }
#pragma unroll
            for (int m = 0; m < MB; ++m)
#pragma unroll
                for (int k = 0; k < 2; ++k) acc[x][m] = __builtin_amdgcn_mfma_f32_16x16x32_bf16(af[m][k], bfr[k], acc[x][m], 0, 0, 0);
        }
    }
    }
    {
        const float w00 = cw[0 * 3072 + c], w01 = cw[1 * 3072 + c], w02 = cw[2 * 3072 + c], b0 = cb[c], fbias = p.in[22][c];
        const bf16_t* r0 = UT + (size_t)c * T_ALL + tok0;
#pragma unroll
        for (int x = 0; x < CBW; ++x)
#pragma unroll
            for (int m = 0; m < MB; ++m) {
                const int col = 16 * (cb0 + x) + fr, i = col >> 3, b = col & 7, r = 16 * (mb0 + m) + 4 * fq, t = 64 * i + r;
                const size_t o = (size_t)b * L + t;
                const u32x2 xr = *(const u32x2*)(r0 + o);
                float xv[6];
                xv[0] = t > 0 ? bf2f(r0[o - 1]) : 0.f; xv[5] = t + 4 < L ? bf2f(r0[o + 4]) : 0.f;
                xv[1] = bf2f(xr.x & 0xffffu); xv[2] = bf2f(xr.x >> 16); xv[3] = bf2f(xr.y & 0xffffu); xv[4] = bf2f(xr.y >> 16);
                const u32x2 zr = *(const LAS u32x2*)(lds + Z_OFF + col * ZSTRIDE + r * 2);
                const float zv[4] = {bf2f(zr.x & 0xffffu), bf2f(zr.x >> 16), bf2f(zr.y & 0xffffu), bf2f(zr.y >> 16)};
                float o4[4];
#pragma unroll
                for (int j = 0; j < 4; ++j) o4[j] = (b0 + w00 * xv[j] + w01 * xv[j + 1] + w02 * xv[j + 2]) * (acc[x][m][j] + fbias * zv[j]);
                u32x2 w; w.x = pack2(o4[0], o4[1]); w.y = pack2(o4[2], o4[3]);
                *(u32x2*)(YT + (size_t)c * T_ALL + tok0 + o) = w;
            }
    }
    __syncthreads();
}
__device__ __forceinline__ void longconv_phase(PARG p, LAS unsigned char* lds) {
    for (int c = blockIdx.x; c < DM; c += gridDim.x) longconv_channel<SEQ>(p, lds, c);
    for (int c = blockIdx.x; c < DM; c += gridDim.x) longconv_channel<CTXL>(p, lds, c);
}

__device__ __forceinline__ void transpose_phase(PARG p, LAS unsigned char* lds) {
    const bf16_t* S = (const bf16_t*)(p.ws + OFF_Y); bf16_t* Dst = (bf16_t*)(p.ws + OFF_H);
    LAS bf16_t* t = (LAS bf16_t*)lds;
    const int tid = threadIdx.x;
    for (int item = blockIdx.x; item < 16 * (T_ALL / 64); item += gridDim.x) {
        const int c0 = (item & 15) * 64, t0 = (item >> 4) * 64;
        { const int c = tid >> 3, t8 = (tid & 7) * 8;
          *(LAS u32x4*)(t + c * 72 + t8) = *(const u32x4*)(S + (size_t)(c0 + c) * T_ALL + t0 + t8); }
        __syncthreads();
        { const int tt = tid >> 3, c8 = (tid & 7) * 8;
          unsigned v[8];
#pragma unroll
          for (int j = 0; j < 8; ++j) v[j] = t[(c8 + j) * 72 + tt];
          u32x4 w; w.x = v[0] | (v[1] << 16); w.y = v[2] | (v[3] << 16); w.z = v[4] | (v[5] << 16); w.w = v[6] | (v[7] << 16);
          *(u32x4*)(Dst + (size_t)(t0 + tt) * DM + c0 + c8) = w; }
        __syncthreads();
    }
}

__device__ __forceinline__ void rgconv_phase(PARG p) {
    const bf16_t* R = (const bf16_t*)(p.ws + OFF_BIG + 37748736); bf16_t* XC = (bf16_t*)(p.ws + OFF_H);
    const float* cw = p.in[27]; const float* cb = p.in[28];
    for (int it = blockIdx.x * 512 + threadIdx.x; it < T_ALL * 128; it += gridDim.x * 512) {
        const int row = it >> 7, c8 = (it & 127) * 8;
        int t, L;
        if (row < T_LAT) { t = row & (SEQ - 1); L = SEQ; } else { t = (row - T_LAT) & (CTXL - 1); L = CTXL; }
        float o[8];
#pragma unroll
        for (int j = 0; j < 8; ++j) o[j] = cb[c8 + j];
#pragma unroll
        for (int k = 0; k < 4; ++k) {
            const int tt = t + k - 1;
            if (tt >= 0 && tt < L) {
                const u32x4 v = *(const u32x4*)(R + (size_t)(row + k - 1) * DM + c8);
                const f32x4 w0 = *(const f32x4*)(cw + k * DM + c8), w1 = *(const f32x4*)(cw + k * DM + c8 + 4);
#pragma unroll
                for (int j = 0; j < 4; ++j) { const float lo = bf2f(v[j] & 0xffffu), hi = bf2f(v[j] >> 16);
                    o[2 * j] += lo * (j < 2 ? w0[2 * j] : w1[2 * j - 4]); o[2 * j + 1] += hi * (j < 2 ? w0[2 * j + 1] : w1[2 * j - 3]); }
            }
        }
        u32x4 w; w.x = pack2(o[0], o[1]); w.y = pack2(o[2], o[3]); w.z = pack2(o[4], o[5]); w.w = pack2(o[6], o[7]);
        *(u32x4*)(XC + (size_t)row * DM + c8) = w;
    }
}

__device__ __forceinline__ int scan_row(int dir, int b, int q) {
    if (q < CTXL) return T_LAT + b * CTXL + (dir ? (CTXL - 1 - q) : q);
    const int t = q - CTXL; return b * SEQ + (dir ? (SEQ - 1 - t) : t);
}
__device__ __forceinline__ void scan_agg_phase(PARG p) {
    const unsigned* GA0 = (const unsigned*)(p.ws + OFF_BIG + 37748736); const unsigned* GA1 = (const unsigned*)(p.ws + OFF_EXTRA);
    f32x2* AGG = (f32x2*)(p.ws + OFF_Y);
    const int lane = threadIdx.x & 63, wv = threadIdx.x >> 6;
    for (int item = blockIdx.x * 8 + wv; item < 2 * 8 * 36 * 16; item += gridDim.x * 8) {
        const int cg_ = item & 15, k = (item >> 4) % 36, b = ((item >> 4) / 36) & 7, dir = (item >> 4) / 288;
        const int ch = cg_ * 64 + lane;
        const unsigned* GA = dir ? GA1 : GA0;
        const int r0 = scan_row(dir, b, 64 * k); const int step = dir ? -1 : 1;
        float A = 1.f, Bv = 0.f;
#pragma unroll 16
        for (int s = 0; s < 64; ++s) {
            const unsigned v = GA[(size_t)(r0 + step * s) * DM + ch];
            const float a = __expf(bf2f(v & 0xffffu)), bb = bf2f(v >> 16);
            A *= a; Bv = a * Bv + bb;
        }
        AGG[(((size_t)dir * 8 + b) * 36 + k) * DM + ch] = (f32x2){A, Bv};
    }
}
__device__ __forceinline__ void scan_out_phase(PARG p) {
    const unsigned* GA0 = (const unsigned*)(p.ws + OFF_BIG + 37748736); const unsigned* GA1 = (const unsigned*)(p.ws + OFF_EXTRA);
    const f32x2* AGG = (const f32x2*)(p.ws + OFF_Y);
    const bf16_t* G = (const bf16_t*)(p.ws + OFF_BIG);
    bf16_t* H = (bf16_t*)(p.ws + OFF_H);
    const int lane = threadIdx.x & 63, wv = threadIdx.x >> 6;
    for (int item = blockIdx.x * 8 + wv; item < 8 * 32 * 16; item += gridDim.x * 8) {
        const int cg_ = item & 15, kl = (item >> 4) & 31, b = item >> 9;
        const int ch = cg_ * 64 + lane;
        float hf = 0.f, hr = 0.f;
        { const f32x2* ag = AGG + ((size_t)0 * 8 + b) * 36 * DM + ch; const int n = 4 + kl;
          for (int k = 0; k < n; ++k) { const f32x2 v = ag[(size_t)k * DM]; hf = v.x * hf + v.y; } }
        { const f32x2* ag = AGG + ((size_t)1 * 8 + b) * 36 * DM + ch; const int n = 4 + (31 - kl);
          for (int k = 0; k < n; ++k) { const f32x2 v = ag[(size_t)k * DM]; hr = v.x * hr + v.y; } }
        const int row0 = b * SEQ + kl * 64;
        float hs[64];
#pragma unroll
        for (int s = 0; s < 64; ++s) {
            const unsigned v = GA0[(size_t)(row0 + s) * DM + ch];
            hf = __expf(bf2f(v & 0xffffu)) * hf + bf2f(v >> 16); hs[s] = hf;
        }
#pragma unroll
        for (int s = 63; s >= 0; --s) {
            const unsigned v = GA1[(size_t)(row0 + s) * DM + ch];
            hr = __expf(bf2f(v & 0xffffu)) * hr + bf2f(v >> 16);
            const float g = bf2f(G[(size_t)(row0 + s) * DM + ch]);
            H[(size_t)(row0 + s) * DM + ch] = (bf16_t)f2bf((hs[s] + hr) * geluf_(g));
        }
    }
}


#define XB_TMO      128
#define XB_XCNT(j)  (256  + 64 * (j))
#define XB_XSUB(j)  (1280 + 64 * (j))
#define XB_XGEN(j)  (2304 + 64 * (j))
#define XB_TOP      3328
#define XB_TOPGEN   3392
#define XCD_BAR_WORDS 3456
#define XB_SPIN_CAP (1u << 18)
__device__ __forceinline__ unsigned xb_ld(unsigned* p)              { return __hip_atomic_load(p, __ATOMIC_RELAXED, __HIP_MEMORY_SCOPE_AGENT); }
__device__ __forceinline__ unsigned xb_add(unsigned* p, unsigned v) { return __hip_atomic_fetch_add(p, v, __ATOMIC_RELAXED, __HIP_MEMORY_SCOPE_AGENT); }
__device__ __forceinline__ unsigned xb_xcc_id() { return (unsigned)__builtin_amdgcn_s_getreg((3 << 11) | 20) & 0xFu; }
#define XB_SPIN(cond, bar) do { unsigned _sp = 0; while (cond) { __builtin_amdgcn_s_sleep(1); \
    if ((++_sp & 255u) == 0u) { if (xb_ld(&(bar)[XB_TMO])) break; if (_sp > XB_SPIN_CAP) { atomicAdd(&(bar)[XB_TMO], 1u); break; } } } } while (0)
struct XcdBarrier { unsigned* bar; unsigned x; volatile LAS unsigned* st; };
__device__ __forceinline__ XcdBarrier xcd_barrier_post(unsigned* bar, volatile LAS unsigned* st) {
    XcdBarrier b; b.bar = bar; b.x = xb_xcc_id(); b.st = st;
    if (threadIdx.x == 0) (void)xb_add(&bar[XB_XCNT(b.x)], 1u);
    return b;
}
__device__ __forceinline__ void xcd_barrier_complete(unsigned* bar, unsigned x, unsigned& nloc, unsigned& nx) {
    const unsigned G = gridDim.x * gridDim.y * gridDim.z;
    unsigned sum, cnt, mine, sp = 0u;
    for (;;) {
        sum = 0u; cnt = 0u; mine = 0u;
#pragma unroll
        for (unsigned j = 0; j < 16; ++j) { const unsigned c = xb_ld(&bar[XB_XCNT(j)]); sum += c; cnt += (c > 0u) ? 1u : 0u; mine = (j == x) ? c : mine; }
        if (sum == G) break;
        __builtin_amdgcn_s_sleep(1);
        if ((++sp & 255u) == 0u) { if (xb_ld(&bar[XB_TMO])) break; if (sp > XB_SPIN_CAP) { atomicAdd(&bar[XB_TMO], 1u); break; } }
    }
    nloc = mine > 0u ? mine : 1u; nx = cnt > 0u ? cnt : 1u;
}
__device__ __forceinline__ void xcd_barrier(const XcdBarrier& b) {
    asm volatile("s_waitcnt vmcnt(0)" ::: "memory");
    __syncthreads();
    if (threadIdx.x == 0) {
        unsigned* bar = b.bar;
        __builtin_amdgcn_s_waitcnt(0);
        unsigned nloc = b.st[0], nx = b.st[1];
        if (nloc == 0u) { xcd_barrier_complete(bar, b.x, nloc, nx); b.st[0] = nloc; b.st[1] = nx; }
        const unsigned old = xb_add(&bar[XB_XSUB(b.x)], 1u);
        const unsigned gen = old / nloc;
        if (old + 1u == (gen + 1u) * nloc) {
            __builtin_amdgcn_fence(__ATOMIC_RELEASE, "agent");
            asm volatile("s_waitcnt vmcnt(0)" ::: "memory");
            const unsigned og = xb_add(&bar[XB_TOP], 1u);
            const unsigned tg = og / nx;
            if (og + 1u == (tg + 1u) * nx) xb_add(&bar[XB_TOPGEN], 1u);
            else XB_SPIN(xb_ld(&bar[XB_TOPGEN]) == tg, bar);
            __builtin_amdgcn_fence(__ATOMIC_ACQUIRE, "agent");
            xb_add(&bar[XB_XGEN(b.x)], 1u);
            asm volatile("s_waitcnt vmcnt(0)" ::: "memory");
        } else {
            XB_SPIN(xb_ld(&bar[XB_XGEN(b.x)]) == gen, bar);
            __builtin_amdgcn_fence(__ATOMIC_ACQUIRE, "agent");
            asm volatile("s_waitcnt vmcnt(0)" ::: "memory");
        }
    }
    __syncthreads();
}

__device__ __forceinline__ void run_gemm1(PARG p, LAS unsigned char* lds, int s, int M) {
    const bf16_t* W = (const bf16_t*)(p.ws + OFF_W);
    pg8::Gemm g{(const bf16_t*)(p.ws + OFF_H), W + (s ? W_13_1 : W_13_0), M, 2 * FF, DM, DM, DM, 1 << 20, 0};
    pg8::StaticOrder S; S.init(T_LAT, g.N, g.K, gridDim.x, blockIdx.x, (M - T_LAT) / 256, 1);
    pg8::EpiSwiglu E{(bf16_t*)(p.ws + OFF_BIG)};
    pg8::gemm_phase(lds, g, S, E);
}
__device__ __forceinline__ void run_gemm2(PARG p, LAS unsigned char* lds, int s, int M) {
    const bf16_t* W = (const bf16_t*)(p.ws + OFF_W);
    pg8::Gemm g{(const bf16_t*)(p.ws + OFF_BIG), W + (s ? W_2_1 : W_2_0), M, DM, FF, FF, FF, 1 << 20, 0};
    pg8::StaticOrder S; S.init(T_LAT, g.N, g.K, gridDim.x, blockIdx.x, (M - T_LAT) / 256, 2);
    pg8::EpiBf16 E{(bf16_t*)(p.ws + OFF_Y), DM, nullptr, nullptr, 0, 0, (bf16_t*)(p.ws + OFF_YP)};
    pg8::gemm_phase(lds, g, S, E);
}

#ifndef PHSEL
#define PHSEL -1
#endif
__device__ __forceinline__ void run_phase(PARG p, LAS unsigned char* lds, int ph) {
    const bf16_t* W = (const bf16_t*)(p.ws + OFF_W);
    switch (ph) {
    case 0: if (PHSEL >= 0 && PHSEL != 0) break; ada_phase(p, lds); filter_phase(p, lds); convert_weights(p, lds, 0); break;
    case 1: if (PHSEL >= 0 && PHSEL != 1) break; ew_phase(p, EwArgs{1, 1, T_ALL, 0.f, 0, 0, 0, 0, 0, 0, 1, 1}); break;
    case 2: if (PHSEL >= 0 && PHSEL != 2) break; run_gemm1(p, lds, 0, T_ALL); break;
    case 3: if (PHSEL >= 0 && PHSEL != 3) break; run_gemm2(p, lds, 0, T_ALL); break;
    case 4: if (PHSEL >= 0 && PHSEL != 4) break; ew_phase(p, EwArgs{0, 1, T_ALL, 0.5f, 0, 2, 1, 0, 2, 3, 4, 2}); break;
    case 5: if (PHSEL >= 0 && PHSEL != 5) break; {
        pg8::Gemm g{W + W_HYIN, (const bf16_t*)(p.ws + OFF_H), 3 * DM, T_ALL, DM, DM, DM, 1 << 20, 0};
        pg8::StaticOrder S; S.init(g.M, g.N, g.K, gridDim.x, blockIdx.x, 0, 1);
        pg8::EpiBf16 E{(bf16_t*)(p.ws + OFF_BIG), T_ALL, nullptr, p.in[11], 0, 0, nullptr};
        pg8::gemm_phase(lds, g, S, E);
    } break;
    case 6: if (PHSEL >= 0 && PHSEL != 6) break; longconv_phase(p, lds); break;
    case 7: if (PHSEL >= 0 && PHSEL != 7) break; transpose_phase(p, lds); break;
    case 8: if (PHSEL >= 0 && PHSEL != 8) break; {
        pg8::Gemm g{(const bf16_t*)(p.ws + OFF_H), W + W_HYOUT, T_ALL, DM, DM, DM, DM, 1 << 20, 0};
        pg8::StaticOrder S; S.init(T_LAT, g.N, g.K, gridDim.x, blockIdx.x, 8, 4);
        pg8::EpiBf16 E{(bf16_t*)(p.ws + OFF_Y), DM, p.in[24], nullptr, 0, 0, (bf16_t*)(p.ws + OFF_YP)};
        pg8::gemm_phase(lds, g, S, E);
    } break;
    case 9: if (PHSEL >= 0 && PHSEL != 9) break; ew_phase(p, EwArgs{0, 1, T_ALL, 1.0f, 0, 5, 3, 0, 4, 6, 7, 4}); break;
    case 10: if (PHSEL >= 0 && PHSEL != 10) break; run_gemm1(p, lds, 1, T_ALL); break;
    case 11: if (PHSEL >= 0 && PHSEL != 11) break; run_gemm2(p, lds, 1, T_ALL); break;
    case 12: if (PHSEL >= 0 && PHSEL != 12) break; ew_phase(p, EwArgs{0, 1, T_ALL, 0.5f, 0, 8, 5, 1, 0, 0, 1, 2}); convert_weights(p, lds, 1);
        if (blockIdx.x == gridDim.x - 1) for (int i = threadIdx.x; i < 2 * DM; i += 512) ((float*)(p.ws + OFF_SP8))[i] = -8.0f * log1pf(__expf(-p.in[33][i]));
        break;
    case 13: if (PHSEL >= 0 && PHSEL != 13) break; run_gemm1(p, lds, 0, T_ALL); break;
    case 14: if (PHSEL >= 0 && PHSEL != 14) break; run_gemm2(p, lds, 0, T_ALL); break;
    case 15: if (PHSEL >= 0 && PHSEL != 15) break; ew_phase(p, EwArgs{0, 1, T_ALL, 0.5f, 1, 2, 1, 1, 2, 3, 4, 2}); break;
    case 16: if (PHSEL >= 0 && PHSEL != 16) break; {
        pg8::Gemm g{(const bf16_t*)(p.ws + OFF_H), W + W_RGIN, T_ALL, 2 * DM, DM, DM, DM, 1 << 20, 0};
        pg8::StaticOrder S; S.init(T_LAT, g.N, g.K, gridDim.x, blockIdx.x, 8, 1);
        pg8::EpiBf16 E{(bf16_t*)(p.ws + OFF_BIG), DM, p.in[26], nullptr, DM, (size_t)T_ALL * DM, nullptr};
        pg8::gemm_phase(lds, g, S, E);
    } break;
    case 17: if (PHSEL >= 0 && PHSEL != 17) break; rgconv_phase(p); break;
    case 18: if (PHSEL >= 0 && PHSEL != 18) break; {
        pg8::Gemm g{(const bf16_t*)(p.ws + OFF_H), W + W_GATE, T_ALL, 4096, 256, DM, 256, 4, 256};
        pg8::StaticOrder S; S.init(T_LAT, g.N, g.K, gridDim.x, blockIdx.x, 8, 1);
        pg8::EpiGate E{(unsigned*)(p.ws + OFF_BIG + 37748736), (unsigned*)(p.ws + OFF_EXTRA), (const bf16_t*)(p.ws + OFF_H), p.in[30], p.in[32], (const float*)(p.ws + OFF_SP8)};
        pg8::gemm_phase(lds, g, S, E);
    } break;
    case 19: if (PHSEL >= 0 && PHSEL != 19) break; scan_agg_phase(p); break;
    case 20: if (PHSEL >= 0 && PHSEL != 20) break; scan_out_phase(p); break;
    case 21: if (PHSEL >= 0 && PHSEL != 21) break; {
        pg8::Gemm g{(const bf16_t*)(p.ws + OFF_H), W + W_RGOUT, T_LAT, DM, DM, DM, DM, 1 << 20, 0};
        pg8::StaticOrder S; S.init(T_LAT, g.N, g.K, gridDim.x, blockIdx.x, 0, 1);
        pg8::EpiBf16 E{(bf16_t*)(p.ws + OFF_Y), DM, p.in[35], nullptr, 0, 0, nullptr};
        pg8::gemm_phase(lds, g, S, E);
    } break;
    case 22: if (PHSEL >= 0 && PHSEL != 22) break; ew_phase(p, EwArgs{0, 1, T_LAT, 1.0f, 1, 5, 3, 1, 4, 6, 7, 1}); break;
    case 23: if (PHSEL >= 0 && PHSEL != 23) break; run_gemm1(p, lds, 1, T_LAT); break;
    case 24: if (PHSEL >= 0 && PHSEL != 24) break; run_gemm2(p, lds, 1, T_LAT); break;
    case 25: if (PHSEL >= 0 && PHSEL != 25) break; ew_phase(p, EwArgs{0, 0, T_LAT, 0.5f, 1, 8, 5, 0, 0, 0, 0, 1}); break;
    default: break;
    }
}

__global__ void __launch_bounds__(512, 2) mega_kernel(Params p) {
    extern __shared__ __attribute__((aligned(16))) unsigned char shm[];
    LAS unsigned char* lds = (LAS unsigned char*)shm;
    cg::grid_group grid = cg::this_grid();
    typedef const __attribute__((address_space(4))) Params* KP;
    const KP kp = (KP)__builtin_amdgcn_kernarg_segment_ptr();
    volatile LAS unsigned* st = (volatile LAS unsigned*)(lds + LDS_MAIN);
    if (threadIdx.x == 0) { st[0] = 0u; st[1] = 0u; }
    __syncthreads();
    XcdBarrier xb; xb.bar = nullptr; xb.x = 0; xb.st = st;
    if (kp->ph_hi - kp->ph_lo > 1) xb = xcd_barrier_post((unsigned*)(kp->ws + OFF_BAR), st);
    if (kp->ph_hi > 4096) grid.sync();
#define PH(k) { KP q = kp; asm volatile("" : "+s"(q)); const int lo_ = q->ph_lo, hi_ = q->ph_hi; if (lo_ <= (k) && (k) < hi_) { run_phase(*q, lds, (k)); if ((REPEAT_MASK >> (k)) & 1u) { xcd_barrier(xb); run_phase(*q, lds, (k)); } if ((k) + 1 < hi_) xcd_barrier(xb); } }
    PH(0) PH(1) PH(2) PH(3) PH(4) PH(5) PH(6) PH(7) PH(8) PH(9) PH(10) PH(11) PH(12) PH(13) PH(14) PH(15) PH(16) PH(17) PH(18) PH(19) PH(20) PH(21) PH(22) PH(23) PH(24) PH(25)
#undef PH
}

#ifndef N_LAUNCH_MODE
#define N_LAUNCH_MODE 0
#endif

extern "C" void kernel_launch(void* const* d_in, const int* in_sizes, int n_in, void* d_out, int out_size, void* d_ws, size_t ws_size, hipStream_t stream) {
    static int grid = 0;
    if (grid == 0) {
        if (n_in != 36 || ws_size < WS_END) { fprintf(stderr, "kernel_launch: unexpected n_in %d / ws_size %zu (need %zu)\n", n_in, ws_size, (size_t)WS_END); grid = -1; return; }
        int dev = 0, cus = 0, per_cu = 0;
        hipGetDevice(&dev);
        hipDeviceGetAttribute(&cus, hipDeviceAttributeMultiprocessorCount, dev);
        if (hipFuncSetAttribute((const void*)mega_kernel, hipFuncAttributeMaxDynamicSharedMemorySize, LDS_BYTES) != hipSuccess) { fprintf(stderr, "hipFuncSetAttribute failed\n"); grid = -1; return; }
        if (hipOccupancyMaxActiveBlocksPerMultiprocessor(&per_cu, (const void*)mega_kernel, 512, LDS_BYTES) != hipSuccess || per_cu < 1) { fprintf(stderr, "occupancy query: %d\n", per_cu); per_cu = 1; }
        (void)hipGetLastError();
        grid = cus * 1;
    }
    if (grid < 0) return;
    Params p{};
    for (int i = 0; i < 36; ++i) p.in[i] = (const float*)d_in[i];
    p.out = (float*)d_out; p.ws = (unsigned char*)d_ws;
#if N_LAUNCH_MODE == 1
    for (int ph = 0; ph < NPHASE; ++ph) {
        p.ph_lo = ph; p.ph_hi = ph + 1;
        hipLaunchKernelGGL(mega_kernel, dim3(grid), dim3(512), LDS_BYTES, stream, p);
    }
#else
    p.ph_lo = 0; p.ph_hi = NPHASE;
    if (hipMemsetAsync((unsigned char*)d_ws + OFF_BAR, 0, XCD_BAR_WORDS * 4, stream) != hipSuccess) { fprintf(stderr, "memset failed\n"); return; }
    void* args[] = {&p};
    hipError_t e = hipLaunchCooperativeKernel((const void*)mega_kernel, dim3(grid), dim3(512), args, LDS_BYTES, stream);
    if (e != hipSuccess) fprintf(stderr, "cooperative launch failed: %s (grid %d)\n", hipGetErrorString(e), grid);
#endif
}
```

```cpp
#include <hip/hip_runtime.h>
#include <hip/hip_cooperative_groups.h>
#include <cstdio>
#include <cstdint>
namespace cg = cooperative_groups;

#define LAS __attribute__((address_space(3)))
typedef unsigned short bf16_t;
typedef short bf16x8 __attribute__((ext_vector_type(8)));
typedef float f32x4 __attribute__((ext_vector_type(4)));
typedef float f32x2 __attribute__((ext_vector_type(2)));
typedef unsigned u32x4 __attribute__((ext_vector_type(4)));
typedef unsigned u32x2 __attribute__((ext_vector_type(2)));

constexpr int T_ALL = 18432, T_LAT = 16384, DM = 1024, FF = 2816, SEQ = 2048, CTXL = 256, NB = 8;
constexpr int LDS_MAIN = 131072;
constexpr int LDS_BYTES = LDS_MAIN + 16;
constexpr int NPHASE = 26;
#define REPEAT_MASK 0u
constexpr size_t OFF_XS = 0;
constexpr size_t OFF_Y = OFF_XS + 8388608;
constexpr size_t OFF_H = OFF_Y + 37748736;
constexpr size_t OFF_BIG = OFF_H + 37748736;
constexpr size_t OFF_W = OFF_BIG + 113246208;
constexpr size_t OFF_MOD = OFF_W + 42991616;
constexpr size_t OFF_EXTRA = OFF_MOD + 663552;
constexpr size_t OFF_SP8 = OFF_EXTRA + 75497472;
constexpr size_t OFF_BAR = OFF_SP8 + 8192;
constexpr size_t WS_END = OFF_BAR + 16384;
constexpr size_t W_13_0 = 0, W_2_0 = 5767168, W_13_1 = 8650752, W_2_1 = 14417920, W_MIX = 17301504;
constexpr size_t W_HYIN = W_MIX, W_HYOUT = W_MIX + 3145728;
constexpr size_t W_RGIN = W_MIX, W_GATE = W_MIX + 2097152, W_RGOUT = W_MIX + 3145728;
constexpr size_t OFF_FILT = OFF_EXTRA;
constexpr size_t OFF_FILTC = OFF_EXTRA + 8388608;
constexpr size_t OFF_YP = OFF_EXTRA + 16777216;

#define PARG const __attribute__((address_space(4))) Params&
struct Params { const float* in[36]; float* out; unsigned char* ws; int ph_lo, ph_hi; };

__device__ __forceinline__ float bf2f(unsigned v) { return __uint_as_float(v << 16); }
__device__ __forceinline__ unsigned f2bf(float f) { unsigned u = __float_as_uint(f); u += 0x7FFFu + ((u >> 16) & 1u); return u >> 16; }
__device__ __forceinline__ unsigned pack2(float lo, float hi) { return f2bf(lo) | (f2bf(hi) << 16); }
__device__ __forceinline__ unsigned cvt_pk_bf16(float lo, float hi) { unsigned r; asm volatile("v_cvt_pk_bf16_f32 %0, %1, %2" : "=v"(r) : "v"(lo), "v"(hi)); return r; }
__device__ __forceinline__ float sigmoidf_(float x) { return 1.0f / (1.0f + __expf(-x)); }
__device__ __forceinline__ float siluf_(float x) { return x / (1.0f + __expf(-x)); }
__device__ __forceinline__ float geluf_(float x) { const float u = 0.7978845608f * (x + 0.044715f * x * x * x); const float e = __expf(2.0f * u); const float t = 1.0f - 2.0f / (e + 1.0f); return 0.5f * x * (1.0f + t); }
__device__ __forceinline__ float wave_sum(float v) {
#pragma unroll
    for (int o = 32; o > 0; o >>= 1) v += __shfl_xor(v, o, 64);
    return v;
}

namespace pg8 {
constexpr int BM = 256, BK = 64, HALF = 128, HTB = HALF * BK * 2, NXCD = 8, WGM = 8;
__host__ __device__ __forceinline__ int lds_byte(int r, int c) { const int st = (r >> 4) * 2 + (c >> 5), rr = r & 15, cc = c & 31, ob = rr * 64 + cc * 2; return st * 1024 + (ob ^ (((ob >> 9) & 1) << 5)); }
__host__ __device__ __forceinline__ void stage_rc(int b, int& R, int& C) { const int st = b / 1024, sb = b % 1024, swz = sb ^ (((sb >> 9) & 1) << 5); R = (st >> 1) * 16 + swz / 64; C = (st & 1) * 32 + (swz % 64) / 2; }
__host__ __device__ __forceinline__ int perm32(int rho) { const int n = rho >> 4, i = rho & 15; return 8 * (i >> 2) + 4 * n + (i & 3); }
struct Unit { int pm, pn, ks, nt, koff; };
struct Gemm { const bf16_t* A; const bf16_t* Bt; int M, N, K, lda, ldb, agrp, agoff; };
struct StaticOrder {
    int nM, nN, nwg, G, c, nctx, KS, ntt;
    __device__ void init(int M_main, int N, int K, int G_, int c_, int ctx_panels, int ks_) { nM = M_main / BM; nN = N / BM; nwg = nM * nN; G = G_; c = c_; nctx = ctx_panels; KS = ks_; ntt = K / BK; }
    __device__ bool next(int i, Unit& u) const {
        const long L = (long)i * G + c;
        if (L >= nwg) {
            int e = (int)(L - nwg); if (e >= nctx * nN * KS) return false;
            u.ks = e % KS; e /= KS; u.pn = e % nN; u.pm = 64 + e / nN; u.nt = ntt / KS; u.koff = u.ks * u.nt * BK; return true;
        }
        int wgid = (int)L; { const int q = nwg / NXCD, r = nwg % NXCD, xcd = wgid % NXCD, off = wgid / NXCD; wgid = (xcd < r ? xcd * (q + 1) : r * (q + 1) + (xcd - r) * q) + off; }
        const int nig = WGM * nN, gid = wgid / nig, fm = gid * WGM, gsz = (nM - fm) < WGM ? (nM - fm) : WGM;
        u.pm = fm + ((wgid % nig) % gsz); u.pn = (wgid % nig) / gsz; u.ks = 0; u.nt = ntt; u.koff = 0; return true;
    }
};

template <class Epi>
__device__ __forceinline__ void gemm_phase(LAS unsigned char* lds, const Gemm g, const StaticOrder& S, const Epi& E) {
    const int tid = threadIdx.x, wid = __builtin_amdgcn_readfirstlane(tid >> 6), lane = tid & 63, wr = wid >> 2, wc = wid & 3, fr = lane & 15, fq = lane >> 4;
    unsigned voffA[2], voffB[2];
#pragma unroll
    for (int i = 0; i < 2; ++i) { int R, C; stage_rc(tid * 16 + i * 8192, R, C); const int Rb = Epi::PERM ? ((R & ~31) + perm32(R & 31)) : R;
        voffA[i] = (unsigned)(R * g.lda + C) * 2u; voffB[i] = (unsigned)(Rb * g.ldb + C) * 2u; }
    const size_t kstep = (size_t)(BK * 2);
    const size_t hstepA = (size_t)HALF * g.lda * 2, hstepB = (size_t)HALF * g.ldb * 2;
    const size_t tstepA = 2 * hstepA, tstepB = 2 * hstepB;
    const unsigned ldsw = (unsigned)wid * 1024u;
    const int aoff = lds_byte(wr * 64 + fr, fq * 8), boff = lds_byte(wc * 32 + fr, fq * 8);
#define PG8_SA(b, h) (((b) * 2 + (h)) * HTB)
#define PG8_SB(b, h) ((4 + (b) * 2 + (h)) * HTB)
#define PG8_STAGE(bufoff, gbase, voff) do { _Pragma("unroll") for (int _i = 0; _i < 2; ++_i) \
        __builtin_amdgcn_global_load_lds((const unsigned*)((const char*)(gbase) + (voff)[_i]), (LAS unsigned*)(lds + (bufoff) + ldsw + _i * 8192), 16, 0, 0); } while (0)
#define PG8_LDA(dst, b, h) do { _Pragma("unroll") for (int m = 0; m < 4; ++m) _Pragma("unroll") for (int k = 0; k < 2; ++k) dst[m][k] = *(const LAS bf16x8*)(lds + PG8_SA(b, h) + aoff + m * 2048 + k * 1024); } while (0)
#define PG8_LDB(dst, b, h) do { _Pragma("unroll") for (int n = 0; n < 2; ++n) _Pragma("unroll") for (int k = 0; k < 2; ++k) dst[n][k] = *(const LAS bf16x8*)(lds + PG8_SB(b, h) + boff + n * 2048 + k * 1024); } while (0)
#define PG8_MMA(ai, bj, At, Bt) do { __builtin_amdgcn_s_setprio(1); _Pragma("unroll") for (int m = 0; m < 4; ++m) _Pragma("unroll") for (int n = 0; n < 2; ++n) _Pragma("unroll") for (int k = 0; k < 2; ++k) \
        acc[ai][bj][m][n] = __builtin_amdgcn_mfma_f32_16x16x32_bf16(Bt[n][k], At[m][k], acc[ai][bj][m][n], 0, 0, 0); __builtin_amdgcn_s_setprio(0); } while (0)
#define PG8_WAIT_V(n) asm volatile("s_waitcnt vmcnt(" #n ")" ::: "memory")
#define PG8_WAIT_L(n) asm volatile("s_waitcnt lgkmcnt(" #n ")" ::: "memory")
#define PG8_BAR __builtin_amdgcn_s_barrier()
#define PG8_SCHED __builtin_amdgcn_sched_barrier(0)
#define PG8_UA(u) ((const char*)g.A + (size_t)(u).pm * tstepA + (size_t)((u).pn / g.agrp) * (size_t)g.agoff * 2 + (size_t)(u).koff * 2)
#define PG8_UB(u) ((const char*)g.Bt + (size_t)(u).pn * tstepB + (size_t)(u).koff * 2)
    Unit cur, nxt; int ui = 0;
    if (!S.next(0, cur)) return;
    f32x4 acc[2][2][4][2];
#pragma unroll
    for (int a = 0; a < 2; ++a)
#pragma unroll
        for (int b = 0; b < 2; ++b)
#pragma unroll
            for (int m = 0; m < 4; ++m)
#pragma unroll
                for (int n = 0; n < 2; ++n) acc[a][b][m][n] = (f32x4){0.f, 0.f, 0.f, 0.f};
    bf16x8 At[4][2], B0[2][2], B1[2][2];
    const char* cA = PG8_UA(cur); const char* cB = PG8_UB(cur);
    PG8_STAGE(PG8_SB(0, 0), cB, voffB); PG8_STAGE(PG8_SA(0, 0), cA, voffA); PG8_STAGE(PG8_SB(0, 1), cB + hstepB, voffB); PG8_STAGE(PG8_SA(0, 1), cA + hstepA, voffA);
    if (wr == 1) PG8_BAR;
    PG8_WAIT_V(4); PG8_BAR;
    PG8_STAGE(PG8_SB(1, 0), cB + kstep, voffB); PG8_STAGE(PG8_SA(1, 0), cA + kstep, voffA); PG8_STAGE(PG8_SB(1, 1), cB + hstepB + kstep, voffB);
    PG8_WAIT_V(6); PG8_BAR;
    for (;;) {
        const bool has_next = S.next(ui + 1, nxt);
        const char* nA = has_next ? PG8_UA(nxt) : cA; const char* nB = has_next ? PG8_UB(nxt) : cB;
        const int nt = cur.nt;
        for (int t = 0; t < nt; t += 2) {
            const bool last = (t == nt - 2);
            const char* a1 = cA + (size_t)(t + 1) * kstep;
            const char* a2 = last ? nA : cA + (size_t)(t + 2) * kstep; const char* b2 = last ? nB : cB + (size_t)(t + 2) * kstep;
            const char* a3 = a2 + kstep; const char* b3 = b2 + kstep;
            PG8_LDB(B0, 0, 0); PG8_SCHED; PG8_LDA(At, 0, 0); PG8_STAGE(PG8_SA(1, 1), a1 + hstepA, voffA);
            PG8_WAIT_L(8); PG8_BAR; PG8_WAIT_L(0); PG8_MMA(0, 0, At, B0); PG8_BAR; PG8_SCHED;
            PG8_LDB(B1, 0, 1); PG8_STAGE(PG8_SB(0, 0), b2, voffB);
            PG8_BAR; PG8_WAIT_L(0); PG8_MMA(0, 1, At, B1); PG8_BAR;
            PG8_LDA(At, 0, 1); PG8_STAGE(PG8_SA(0, 0), a2, voffA);
            PG8_BAR; PG8_WAIT_L(0); PG8_MMA(1, 0, At, B0); PG8_BAR; PG8_SCHED;
            PG8_STAGE(PG8_SB(0, 1), b2 + hstepB, voffB);
            PG8_WAIT_V(6); PG8_BAR; PG8_MMA(1, 1, At, B1); PG8_BAR;
            PG8_LDB(B0, 1, 0); PG8_SCHED; PG8_LDA(At, 1, 0); PG8_STAGE(PG8_SA(0, 1), a2 + hstepA, voffA);
            PG8_WAIT_L(8); PG8_BAR; PG8_WAIT_L(0); PG8_MMA(0, 0, At, B0); PG8_BAR; PG8_SCHED;
            PG8_LDB(B1, 1, 1); PG8_STAGE(PG8_SB(1, 0), b3, voffB);
            PG8_BAR; PG8_WAIT_L(0); PG8_MMA(0, 1, At, B1); PG8_BAR;
            PG8_LDA(At, 1, 1); PG8_STAGE(PG8_SA(1, 0), a3, voffA);
            PG8_BAR; PG8_WAIT_L(0); PG8_MMA(1, 0, At, B0); PG8_BAR; PG8_SCHED;
            PG8_STAGE(PG8_SB(1, 1), b3 + hstepB, voffB);
            PG8_WAIT_V(6); PG8_BAR; PG8_MMA(1, 1, At, B1); PG8_BAR;
        }
        E(acc, cur, wr, wc, fr, fq);
        if (!has_next) break;
#pragma unroll
        for (int a = 0; a < 2; ++a)
#pragma unroll
            for (int b = 0; b < 2; ++b)
#pragma unroll
                for (int m = 0; m < 4; ++m)
#pragma unroll
                    for (int n = 0; n < 2; ++n) acc[a][b][m][n] = (f32x4){0.f, 0.f, 0.f, 0.f};
        cur = nxt; cA = nA; cB = nB; ++ui;
    }
    PG8_WAIT_V(0);
    if (wr == 0) PG8_BAR;
    PG8_BAR;
#undef PG8_SA
#undef PG8_SB
#undef PG8_STAGE
#undef PG8_LDA
#undef PG8_LDB
#undef PG8_MMA
#undef PG8_WAIT_V
#undef PG8_WAIT_L
#undef PG8_BAR
#undef PG8_SCHED
#undef PG8_UA
#undef PG8_UB
}

struct EpiSwiglu {
    static constexpr bool PERM = true;
    bf16_t* O;
    __device__ __forceinline__ void operator()(const f32x4 (&acc)[2][2][4][2], const Unit& u, int wr, int wc, int fr, int fq) const {
        const int row0 = u.pm * BM + wr * 64 + fr, col0 = u.pn * 128 + wc * 32 + 8 * fq;
#pragma unroll
        for (int ai = 0; ai < 2; ++ai)
#pragma unroll
            for (int m = 0; m < 4; ++m) {
                bf16_t* rowp = O + (size_t)(row0 + ai * HALF + m * 16) * FF + col0;
                float v[8];
#pragma unroll
                for (int n = 0; n < 2; ++n)
#pragma unroll
                    for (int j = 0; j < 4; ++j) v[n * 4 + j] = siluf_(acc[ai][0][m][n][j]) * acc[ai][1][m][n][j];
                u32x4 w; w.x = cvt_pk_bf16(v[0], v[1]); w.y = cvt_pk_bf16(v[2], v[3]); w.z = cvt_pk_bf16(v[4], v[5]); w.w = cvt_pk_bf16(v[6], v[7]);
                *(u32x4*)rowp = w;
            }
    }
};
struct EpiBf16 {
    static constexpr bool PERM = true;
    bf16_t* O; int ldc; const float* cbias; const float* rbias; int split_cols; size_t split_stride; bf16_t* P;
    __device__ __forceinline__ void operator()(const f32x4 (&acc)[2][2][4][2], const Unit& u, int wr, int wc, int fr, int fq) const {
        const int row0 = u.pm * BM + wr * 64 + fr; int colt = u.pn * BM; bf16_t* base = O;
        const bool part = u.ks > 0;
        if (part) base = P + (size_t)(u.ks - 1) * (2048 * DM) - (size_t)T_LAT * ldc;
        if (split_cols) { const int t = colt / split_cols; base += (size_t)t * split_stride; colt -= t * split_cols; }
        const int col0 = colt + wc * 32 + 8 * fq, bcol0 = u.pn * BM + wc * 32 + 8 * fq;
        f32x4 bv[2][2];
#pragma unroll
        for (int bj = 0; bj < 2; ++bj)
#pragma unroll
            for (int n = 0; n < 2; ++n) bv[bj][n] = (cbias && !part) ? *(const f32x4*)(cbias + bcol0 + bj * HALF + 4 * n) : (f32x4){0.f, 0.f, 0.f, 0.f};
#pragma unroll
        for (int ai = 0; ai < 2; ++ai)
#pragma unroll
            for (int m = 0; m < 4; ++m) {
                const int row = row0 + ai * HALF + m * 16;
                const float rb = rbias ? rbias[row] : 0.f;
                bf16_t* rowp = base + (size_t)row * ldc + col0;
#pragma unroll
                for (int bj = 0; bj < 2; ++bj) { f32x4 v0 = acc[ai][bj][m][0] + bv[bj][0] + rb, v1 = acc[ai][bj][m][1] + bv[bj][1] + rb;
                    u32x4 w; w.x = cvt_pk_bf16(v0[0], v0[1]); w.y = cvt_pk_bf16(v0[2], v0[3]); w.z = cvt_pk_bf16(v1[0], v1[1]); w.w = cvt_pk_bf16(v1[2], v1[3]);
                    *(u32x4*)(rowp + bj * HALF) = w; }
            }
    }
};
__device__ __forceinline__ float dpp_shr(float oldv, float v, int sh) {
    int r;
    switch (sh) {
    case 1: r = __builtin_amdgcn_update_dpp(__float_as_int(oldv), __float_as_int(v), 0x111, 0xf, 0xf, false); break;
    case 2: r = __builtin_amdgcn_update_dpp(__float_as_int(oldv), __float_as_int(v), 0x112, 0xf, 0xf, false); break;
    case 4: r = __builtin_amdgcn_update_dpp(__float_as_int(oldv), __float_as_int(v), 0x114, 0xf, 0xf, false); break;
    default: r = __builtin_amdgcn_update_dpp(__float_as_int(oldv), __float_as_int(v), 0x118, 0xf, 0xf, false); break;
    }
    return __int_as_float(r);
}
__device__ __forceinline__ float dpp_shl(float oldv, float v, int sh) {
    int r;
    switch (sh) {
    case 1: r = __builtin_amdgcn_update_dpp(__float_as_int(oldv), __float_as_int(v), 0x101, 0xf, 0xf, false); break;
    case 2: r = __builtin_amdgcn_update_dpp(__float_as_int(oldv), __float_as_int(v), 0x102, 0xf, 0xf, false); break;
    case 4: r = __builtin_amdgcn_update_dpp(__float_as_int(oldv), __float_as_int(v), 0x104, 0xf, 0xf, false); break;
    default: r = __builtin_amdgcn_update_dpp(__float_as_int(oldv), __float_as_int(v), 0x108, 0xf, 0xf, false); break;
    }
    return __int_as_float(r);
}
struct EpiGate {
    static constexpr bool PERM = false;
    unsigned* GA0; unsigned* GA1; const bf16_t* XC; const float* ba; const float* bi; const float* lam; f32x2* AGG;
    __device__ __forceinline__ void operator()(const f32x4 (&acc)[2][2][4][2], const Unit& u, int wr, int wc, int fr, int fq) const {
        const int row0 = u.pm * BM + wr * 64 + fr;
        const int ch0 = (u.pn >> 2) * 256 + (u.pn & 3) * 64 + wc * 16 + fq * 4;
        const bool isctx = u.pm >= 64;
        const int bseq = isctx ? (u.pm - 64) : (u.pm >> 3);
#pragma unroll
        for (int d = 0; d < 2; ++d) {
            unsigned* GA = d ? GA1 : GA0;
#pragma unroll
            for (int ai = 0; ai < 2; ++ai) {
                float Aq[4], Bq[4];
#pragma unroll
                for (int j = 0; j < 4; ++j) { Aq[j] = 1.f; Bq[j] = 0.f; }
#pragma unroll
                for (int m0 = 0; m0 < 4; ++m0) {
                    const int m = d ? 3 - m0 : m0;
                    const int row = row0 + ai * HALF + m * 16;
                    const f32x4 bav = *(const f32x4*)(ba + d * DM + ch0), biv = *(const f32x4*)(bi + d * DM + ch0), spv = *(const f32x4*)(lam + d * DM + ch0);
                    const u32x2 xr = *(const u32x2*)(XC + (size_t)row * DM + ch0);
                    const float xc[4] = {bf2f(xr.x & 0xffffu), bf2f(xr.x >> 16), bf2f(xr.y & 0xffffu), bf2f(xr.y >> 16)};
                    u32x4 w;
#pragma unroll
                    for (int j = 0; j < 4; ++j) {
                        const float rr = sigmoidf_(acc[ai][d][m][0][j] + bav[j]);
                        const float ii = sigmoidf_(acc[ai][d][m][1][j] + biv[j]);
                        const float la = rr * spv[j];
                        const float bb = sqrtf(fmaxf(1.0f - __expf(2.0f * la), 0.f)) * ii * xc[j];
                        w[j] = cvt_pk_bf16(la, bb);
                    }
                    *(u32x4*)(GA + (size_t)row * DM + ch0) = w;
#pragma unroll
                    for (int j = 0; j < 4; ++j) {
                        float a = __expf(bf2f(w[j] & 0xffffu)), b = bf2f(w[j] >> 16);
#pragma unroll
                        for (int sh = 1; sh < 16; sh <<= 1) {
                            const float ap = d ? dpp_shl(1.f, a, sh) : dpp_shr(1.f, a, sh);
                            const float bp = d ? dpp_shl(0.f, b, sh) : dpp_shr(0.f, b, sh);
                            b = a * bp + b; a = a * ap;
                        }
                        Bq[j] = a * Bq[j] + b; Aq[j] = a * Aq[j];
                    }
                    asm volatile("" ::: "memory");
                }
                if (fr == (d ? 0 : 15)) {
                    const int c64 = 2 * ai + wr;
                    int k;
                    if (isctx) k = d ? 3 - c64 : c64;
                    else { const int kl = (u.pm & 7) * 4 + c64; k = 4 + (d ? 31 - kl : kl); }
                    f32x2* dst = AGG + (((size_t)d * 8 + bseq) * 36 + k) * DM + ch0;
                    *(f32x4*)dst = (f32x4){Aq[0], Bq[0], Aq[1], Bq[1]};
                    *(f32x4*)(dst + 2) = (f32x4){Aq[2], Bq[2], Aq[3], Bq[3]};
                }
            }
        }
    }
};
}

__device__ __forceinline__ void convT_tile(LAS unsigned char* lds, const float* src, int N, int K, bf16_t* dst, int mode, int aux, int tile) {
    LAS float* t = (LAS float*)lds;
    const int ntn = N / 256, tk = tile / ntn, tn = tile % ntn, k0 = tk * 64, n0 = tn * 256, tid = threadIdx.x;
    {
        const int kk = tid >> 6, n4 = (tid & 63) * 4;
        f32x4 v[8];
#pragma unroll
        for (int i = 0; i < 8; ++i) v[i] = *(const f32x4*)(src + (size_t)(k0 + kk + 8 * i) * N + n0 + n4);
#pragma unroll
        for (int i = 0; i < 8; ++i)
#pragma unroll
            for (int j = 0; j < 4; ++j) t[(kk + 8 * i) * 257 + n4 + j] = v[i][j];
    }
    __syncthreads();
#pragma unroll
    for (int i = 0; i < 4; ++i) {
        const int pi = tid + 512 * i, n = pi >> 3, k8 = (pi & 7) * 8, ng = n0 + n;
        int row;
        if (mode == 0) row = ng;
        else if (mode == 1) row = (ng >> 7) * 256 + (ng & 127);
        else if (mode == 2) row = (ng >> 7) * 256 + 128 + (ng & 127);
        else { const int d = aux & 1, gate = (aux >> 1) & 1, h = aux >> 2; const int pn = 4 * h + (ng >> 6), q = ng & 63;
               row = 256 * pn + 128 * d + 32 * (q >> 4) + 16 * gate + (q & 15); }
        float v[8];
#pragma unroll
        for (int j = 0; j < 8; ++j) v[j] = t[(k8 + j) * 257 + n];
        u32x4 w; w.x = pack2(v[0], v[1]); w.y = pack2(v[2], v[3]); w.z = pack2(v[4], v[5]); w.w = pack2(v[6], v[7]);
        *(u32x4*)(dst + (size_t)row * K + k0 + k8) = w;
    }
    __syncthreads();
}

__device__ __forceinline__ int conv_items(PARG p, LAS unsigned char* lds, int layer, int tile) {
    bf16_t* W = (bf16_t*)(p.ws + OFF_W);
    int base = 0;
#define CONV_MAT(SRC, NN, KK, DST, MODE, AUX) { const int cnt = ((NN) / 256) * ((KK) / 64); if (tile >= base && tile < base + cnt) { convT_tile(lds, (SRC), (NN), (KK), (DST), (MODE), (AUX), tile - base); return -1; } base += cnt; }
    for (int s = 0; s < 2; ++s) {
        const size_t o = ((size_t)layer * 2 + s) * DM * FF;
        bf16_t* w13 = W + (s ? W_13_1 : W_13_0); bf16_t* w2 = W + (s ? W_2_1 : W_2_0);
        CONV_MAT(p.in[7] + o, FF, DM, w13, 1, 0)
        CONV_MAT(p.in[8] + o, FF, DM, w13, 2, 0)
        CONV_MAT(p.in[9] + o, DM, FF, w2, 0, 0)
    }
    if (layer == 0) {
        CONV_MAT(p.in[10], 3 * DM, DM, W + W_HYIN, 0, 0)
        CONV_MAT(p.in[23], DM, DM, W + W_HYOUT, 0, 0)
    } else {
        CONV_MAT(p.in[25], 2 * DM, DM, W + W_RGIN, 0, 0)
        CONV_MAT(p.in[34], DM, DM, W + W_RGOUT, 0, 0)
        for (int d = 0; d < 2; ++d) for (int h = 0; h < 4; ++h) {
            CONV_MAT(p.in[29] + ((size_t)d * 4 + h) * 65536, 256, 256, W + W_GATE, 3, d | (0 << 1) | (h << 2))
            CONV_MAT(p.in[31] + ((size_t)d * 4 + h) * 65536, 256, 256, W + W_GATE, 3, d | (1 << 1) | (h << 2))
        }
    }
#undef CONV_MAT
    return base;
}
__device__ __forceinline__ void convert_weights(PARG p, LAS unsigned char* lds, int layer) {
    const int total = conv_items(p, lds, layer, -1);
    for (int t = blockIdx.x; t < total; t += gridDim.x) conv_items(p, lds, layer, t);
}

__device__ __forceinline__ void ada_phase(PARG p, LAS unsigned char* lds) {
    LAS float* sc = (LAS float*)lds;
    LAS float* red = sc + 9 * 1024;
    const int tid = threadIdx.x;
    bool loaded = false;
    float* MOD = (float*)(p.ws + OFF_MOD);
    for (int item = blockIdx.x; item < 288; item += gridDim.x) {
        if (!loaded) {
            for (int i = tid; i < 9 * 1024; i += 512) { const float v = (i < 8192) ? p.in[1][i] : p.in[3][i - 8192]; sc[i] = siluf_(v); }
            __syncthreads(); loaded = true;
        }
        const int l = item / 144, n0 = (item % 144) * 64, kc = tid >> 6, col = tid & 63;
        const float* w = p.in[4] + (size_t)l * DM * 9216 + n0 + col;
        float a[9];
#pragma unroll
        for (int m = 0; m < 9; ++m) a[m] = 0.f;
#pragma unroll 1
        for (int k0 = kc * 128; k0 < kc * 128 + 128; k0 += 32) {
            float wv[32];
#pragma unroll
            for (int i = 0; i < 32; ++i) wv[i] = w[(size_t)(k0 + i) * 9216];
#pragma unroll
            for (int i = 0; i < 32; ++i)
#pragma unroll
                for (int m = 0; m < 9; ++m) a[m] += sc[m * 1024 + k0 + i] * wv[i];
        }
#pragma unroll
        for (int m = 0; m < 9; ++m) red[(kc * 9 + m) * 64 + col] = a[m];
        __syncthreads();
        for (int i = tid; i < 9 * 64; i += 512) {
            const int m = i >> 6, c2 = i & 63; float s = 0.f;
#pragma unroll
            for (int q = 0; q < 8; ++q) s += red[(q * 9 + m) * 64 + c2];
            MOD[((size_t)l * 9 + m) * 9216 + n0 + c2] = s + p.in[5][(size_t)l * 9216 + n0 + c2];
        }
        __syncthreads();
    }
    __syncthreads();
}

__device__ __forceinline__ void filter_item(PARG p, LAS unsigned char* lds, int L, int k0, bf16_t* FT, int ldq) {
    LAS float* zf = (LAS float*)lds;
    LAS float* hA = zf + 16 * 64;
    LAS float* hB = hA + 16 * 64;
    LAS float* W0 = hB + 16 * 64;
    LAS float* W1 = W0 + 33 * 64;
    LAS float* W2 = W1 + 64 * 64;
    const int tid = threadIdx.x, w = tid >> 6, lane = tid & 63;
    const float* fb0 = p.in[15]; const float* fb1 = p.in[17]; const float* fb2 = p.in[19]; const float* freq = p.in[20]; const float* fwout = p.in[21];
    for (int i = tid; i < 33 * 64; i += 512) W0[i] = p.in[14][i];
    for (int i = tid; i < 64 * 64; i += 512) { W1[i] = p.in[16][i]; W2[i] = p.in[18][i]; }
#pragma unroll 1
    for (int pp = 0; pp < 2; ++pp) {
        const int pi = w * 2 + pp, k = k0 + pi;
        float f = 0.f;
        if (lane == 0) f = (float)k / (float)(L - 1);
        else if (lane < 33) {
            const int band = (lane - 1) & 15;
            const float fr = 1e-4f + (float)band * ((15.0f - 1e-4f) / 15.0f);
            const float wk = 6.283185307179586f * (float)k / (float)L;
            const float ph = fr * wk;
            f = (lane <= 16) ? cosf(ph) : -sinf(ph);
        }
        zf[pi * 64 + lane] = f;
    }
    __syncthreads();
    {
        const float b0 = fb0[lane], f0 = freq[lane];
        float a0 = b0, a1 = b0;
#pragma unroll 11
        for (int e = 0; e < 33; ++e) { const float wv = W0[e * 64 + lane]; a0 += zf[(w * 2) * 64 + e] * wv; a1 += zf[(w * 2 + 1) * 64 + e] * wv; }
        hA[(w * 2) * 64 + lane] = sinf(f0 * a0); hA[(w * 2 + 1) * 64 + lane] = sinf(f0 * a1);
    }
    __syncthreads();
    {
        const float b0 = fb1[lane], f0 = freq[64 + lane];
        float a0 = b0, a1 = b0;
#pragma unroll 16
        for (int e = 0; e < 64; ++e) { const float wv = W1[e * 64 + lane]; a0 += hA[(w * 2) * 64 + e] * wv; a1 += hA[(w * 2 + 1) * 64 + e] * wv; }
        hB[(w * 2) * 64 + lane] = sinf(f0 * a0); hB[(w * 2 + 1) * 64 + lane] = sinf(f0 * a1);
    }
    __syncthreads();
    {
        const float b0 = fb2[lane], f0 = freq[128 + lane];
        float a0 = b0, a1 = b0;
#pragma unroll 16
        for (int e = 0; e < 64; ++e) { const float wv = W2[e * 64 + lane]; a0 += hB[(w * 2) * 64 + e] * wv; a1 += hB[(w * 2 + 1) * 64 + e] * wv; }
        __syncthreads();
        hA[(w * 2) * 64 + lane] = sinf(f0 * a0); hA[(w * 2 + 1) * 64 + lane] = sinf(f0 * a1);
    }
    __syncthreads();
    const float min_decay = -3.0701134573253945f, max_decay = -15.350567286626973f;
#pragma unroll 1
    for (int q = 0; q < 4; ++q) {
        const int n = tid + 512 * q;
        float acc[16];
#pragma unroll
        for (int i = 0; i < 16; ++i) acc[i] = 0.f;
#pragma unroll 1
        for (int e0 = 0; e0 < 64; e0 += 32) {
            float wv[32];
#pragma unroll
            for (int e = 0; e < 32; ++e) wv[e] = fwout[(e0 + e) * 2048 + n];
#pragma unroll
            for (int e = 0; e < 32; ++e)
#pragma unroll
                for (int i = 0; i < 16; ++i) acc[i] += hA[i * 64 + e0 + e] * wv[e];
        }
        const int c = n & 1023; const bool bwd = n >= 1024;
        const float delta = fabsf(min_decay + (float)c * ((max_decay - min_decay) / 1023.0f));
        bf16_t* dst = FT + (size_t)c * ldq;
#pragma unroll
        for (int i = 0; i < 16; ++i) {
            const int k = k0 + i;
            const float tk = (float)k / (float)(L - 1);
            const float val = acc[i] * __expf(-tk * delta);
            if (!bwd) dst[(L - 1) - k] = (bf16_t)f2bf(val);
            else if (k >= 1) dst[(L - 1) + k] = (bf16_t)f2bf(val);
        }
        if (k0 == 0 && !bwd) dst[2 * L - 1] = 0;
    }
    __syncthreads();
}
__device__ __forceinline__ void filter_phase(PARG p, LAS unsigned char* lds) {
    for (int item = (int)gridDim.x - 1 - (int)blockIdx.x; item < 144; item += gridDim.x) {
        if (item < 128) filter_item(p, lds, SEQ, item * 16, (bf16_t*)(p.ws + OFF_FILT), 4096);
        else filter_item(p, lds, CTXL, (item - 128) * 16, (bf16_t*)(p.ws + OFF_FILTC), 512);
    }
}

struct EwArgs { int init; int has_h; int nrows; float coef; int lres, gate_i, gpost_i; int lh, gpre_i, shift_i, scale_i; int nks; };
__device__ __forceinline__ void ew_phase(PARG p, const EwArgs a) {
    const int lane = threadIdx.x & 63, wv = threadIdx.x >> 6;
    const float* MOD = (const float*)(p.ws + OFF_MOD);
    const float* NG = p.in[6];
    const bf16_t* Y = (const bf16_t*)(p.ws + OFF_Y);
    bf16_t* H = (bf16_t*)(p.out);
    for (int row = blockIdx.x * 8 + wv; row < a.nrows; row += gridDim.x * 8) {
        const int midx = row < T_LAT ? (row >> 11) : 8;
        bf16_t* xp = (bf16_t*)(p.ws + OFF_H) + (size_t)row * DM;
        f32x4 x[4], g[4], sh[4], scl[4];
        if (a.has_h) {
#pragma unroll
            for (int q = 0; q < 4; ++q) {
                const int col = q * 256 + lane * 4;
                g[q] = *(const f32x4*)(NG + ((size_t)a.lh * 6 + a.gpre_i) * DM + col);
                sh[q] = *(const f32x4*)(MOD + ((size_t)a.lh * 9 + midx) * 9216 + a.shift_i * DM + col);
                scl[q] = *(const f32x4*)(MOD + ((size_t)a.lh * 9 + midx) * 9216 + a.scale_i * DM + col);
            }
        }
        if (a.init) {
            if (row < T_LAT) {
                const int t = row & (SEQ - 1); const float pr = (float)(t >> 6), pc = (float)(t & 63);
#pragma unroll
                for (int q = 0; q < 4; ++q) {
                    const int col = q * 256 + lane * 4;
                    f32x4 v = *(const f32x4*)(p.in[0] + (size_t)row * DM + col);
#pragma unroll
                    for (int j = 0; j < 4; ++j) {
                        const int d = col + j, i = d & 255;
                        const float om = __expf(-(float)i * (9.210340371976184f / 256.0f));
                        const float ang = ((d < 512) ? pr : pc) * om;
                        v[j] += ((d >> 8) & 1) ? cosf(ang) : sinf(ang);
                    }
                    x[q] = v;
                }
            } else {
#pragma unroll
                for (int q = 0; q < 4; ++q) x[q] = *(const f32x4*)(p.in[2] + (size_t)(row - T_LAT) * DM + q * 256 + lane * 4);
            }
        } else {
            f32x4 y[4], gt[4], gp[4]; u32x2 yr[4]; float ss = 0.f;
#pragma unroll
            for (int q = 0; q < 4; ++q) {
                const int col = q * 256 + lane * 4;
                { const u32x2 xv = *(const u32x2*)(xp + col); x[q] = (f32x4){bf2f(xv.x & 0xffffu), bf2f(xv.x >> 16), bf2f(xv.y & 0xffffu), bf2f(xv.y >> 16)}; }
                yr[q] = *(const u32x2*)(Y + (size_t)row * DM + col);
                gt[q] = *(const f32x4*)(MOD + ((size_t)a.lres * 9 + midx) * 9216 + a.gate_i * DM + col);
                gp[q] = *(const f32x4*)(NG + ((size_t)a.lres * 6 + a.gpost_i) * DM + col);
            }
#pragma unroll
            for (int q = 0; q < 4; ++q) {
                y[q] = (f32x4){bf2f(yr[q].x & 0xffffu), bf2f(yr[q].x >> 16), bf2f(yr[q].y & 0xffffu), bf2f(yr[q].y >> 16)};
                if (row >= T_LAT) for (int k = 0; k + 1 < a.nks; ++k) {
                    const u32x2 pr2 = *(const u32x2*)((const bf16_t*)(p.ws + OFF_YP) + ((size_t)k * 2048 + (row - T_LAT)) * DM + q * 256 + lane * 4);
                    y[q] = y[q] + (f32x4){bf2f(pr2.x & 0xffffu), bf2f(pr2.x >> 16), bf2f(pr2.y & 0xffffu), bf2f(pr2.y >> 16)};
                }
#pragma unroll
                for (int j = 0; j < 4; ++j) ss += y[q][j] * y[q][j];
            }
            ss = wave_sum(ss);
            const float r = a.coef * rsqrtf(ss * (1.0f / DM) + 1e-6f);
#pragma unroll
            for (int q = 0; q < 4; ++q) x[q] = x[q] + (r * gt[q]) * (y[q] * gp[q]);
        }
        if (!a.has_h) {
#pragma unroll
            for (int q = 0; q < 4; ++q) *(f32x4*)(p.out + (size_t)row * DM + q * 256 + lane * 4) = x[q];
        } else {
#pragma unroll
            for (int q = 0; q < 4; ++q) { u32x2 w; w.x = pack2(x[q][0], x[q][1]); w.y = pack2(x[q][2], x[q][3]); *(u32x2*)(xp + q * 256 + lane * 4) = w; }
        }
        if (a.has_h) {
            float ss = 0.f;
#pragma unroll
            for (int q = 0; q < 4; ++q)
#pragma unroll
                for (int j = 0; j < 4; ++j) ss += x[q][j] * x[q][j];
            ss = wave_sum(ss);
            const float r = rsqrtf(ss * (1.0f / DM) + 1e-6f);
#pragma unroll
            for (int q = 0; q < 4; ++q) {
                const int col = q * 256 + lane * 4;
                const f32x4 h = (x[q] * r) * g[q] * (scl[q] + 1.0f) + sh[q];
                u32x2 w; w.x = pack2(h[0], h[1]); w.y = pack2(h[2], h[3]);
                *(u32x2*)(H + (size_t)row * DM + col) = w;
            }
        }
    }
}

template <int L>
__device__ __forceinline__ void longconv_channel(PARG p, LAS unsigned char* lds, int c) {
    constexpr int NBLK = L / 64, NCOL = NBLK * 8, FLEN = 2 * L, CSTRIDE = FLEN * 2 + 32, ZSTRIDE = 144;
    constexpr int Z_OFF = 8 * CSTRIDE;
    constexpr int MB = (L == SEQ) ? 4 : 1, CBW = (L == SEQ) ? 2 : 1;
    static_assert(Z_OFF + NCOL * ZSTRIDE <= LDS_MAIN, "lds");
    const int tid = threadIdx.x, wid = tid >> 6, lane = tid & 63, fr = lane & 15, fq = lane >> 4;
    const int tok0 = (L == SEQ) ? 0 : T_LAT;
    const bf16_t* UT = (const bf16_t*)(p.ws + OFF_BIG);
    const bf16_t* FT = (L == SEQ) ? (const bf16_t*)(p.ws + OFF_FILT) + (size_t)c * 4096 : (const bf16_t*)(p.ws + OFF_FILTC) + (size_t)c * 512;
    bf16_t* YT = (bf16_t*)(p.ws + OFF_Y);
    const float* cw = p.in[12]; const float* cb = p.in[13];
    for (int v = tid; v < FLEN / 8; v += 512) *(LAS u32x4*)(lds + v * 16) = *(const u32x4*)(FT + v * 8);
    {
        const float w10 = cw[0 * 3072 + 1024 + c], w11 = cw[1 * 3072 + 1024 + c], w12 = cw[2 * 3072 + 1024 + c], b1 = cb[1024 + c];
        const float w20 = cw[0 * 3072 + 2048 + c], w21 = cw[1 * 3072 + 2048 + c], w22 = cw[2 * 3072 + 2048 + c], b2 = cb[2048 + c];
        const bf16_t* r1 = UT + (size_t)(1024 + c) * T_ALL + tok0; const bf16_t* r2 = UT + (size_t)(2048 + c) * T_ALL + tok0;
        for (int g = tid; g < NB * L / 8; g += 512) {
            const int b = g / (L / 8), t0 = (g % (L / 8)) * 8;
            const size_t o = (size_t)b * L + t0;
            const u32x4 a = *(const u32x4*)(r1 + o); const u32x4 bq = *(const u32x4*)(r2 + o);
            float x1[10], x2[10];
            x1[0] = t0 > 0 ? bf2f(r1[o - 1]) : 0.f; x2[0] = t0 > 0 ? bf2f(r2[o - 1]) : 0.f;
            x1[9] = t0 + 8 < L ? bf2f(r1[o + 8]) : 0.f; x2[9] = t0 + 8 < L ? bf2f(r2[o + 8]) : 0.f;
#pragma unroll
            for (int j = 0; j < 4; ++j) { x1[1 + 2 * j] = bf2f(a[j] & 0xffffu); x1[2 + 2 * j] = bf2f(a[j] >> 16); x2[1 + 2 * j] = bf2f(bq[j] & 0xffffu); x2[2 + 2 * j] = bf2f(bq[j] >> 16); }
            float z[8];
#pragma unroll
            for (int j = 0; j < 8; ++j) z[j] = (b1 + w10 * x1[j] + w11 * x1[j + 1] + w12 * x1[j + 2]) * (b2 + w20 * x2[j] + w21 * x2[j + 1] + w22 * x2[j + 2]);
            u32x4 w; w.x = pack2(z[0], z[1]); w.y = pack2(z[2], z[3]); w.z = pack2(z[4], z[5]); w.w = pack2(z[6], z[7]);
            *(LAS u32x4*)(lds + Z_OFF + ((t0 >> 6) * 8 + b) * ZSTRIDE + (t0 & 63) * 2) = w;
        }
    }
    __syncthreads();
    {
        const LAS unsigned* D = (const LAS unsigned*)lds;
        for (int v = tid; v < FLEN / 8; v += 512) {
            unsigned d[8];
#pragma unroll
            for (int i = 0; i < 8; ++i) d[i] = D[4 * v + i];
#pragma unroll
            for (int j = 1; j < 8; ++j) {
                u32x4 w;
#pragma unroll
                for (int i = 0; i < 4; ++i) w[i] = (j & 1) ? __builtin_amdgcn_alignbyte(d[i + (j + 1) / 2], d[i + (j - 1) / 2], 2) : d[i + j / 2];
                *(LAS u32x4*)(lds + j * CSTRIDE + v * 16) = w;
            }
        }
    }
    __syncthreads();
    const int mb0 = (L == SEQ) ? 0 : (wid & 3), cb0 = (L == SEQ) ? 2 * wid : (wid >> 2);
    f32x4 acc[CBW][MB];
#pragma unroll
    for (int x = 0; x < CBW; ++x)
#pragma unroll
        for (int m = 0; m < MB; ++m) acc[x][m] = (f32x4){0.f, 0.f, 0.f, 0.f};
    const int jj = (7 - fr) & 7;
    const int abase = jj * CSTRIDE + 2 * ((L - 1) - fr - jj + 8 * fq);
    const int ilo = 2 * cb0, ihi = 2 * (cb0 + CBW) - 1;
    if constexpr (L == SEQ) {
        const int col = 16 * cb0 + fr, ib = col >> 3;
        auto getB = [&](int dd, bf16x8 (&o)[2]) {
            const int ip = ib - dd; const bool ok = (ip >= 0) && (ip < NBLK); const int colp = ok ? col - 8 * dd : col;
#pragma unroll
            for (int k = 0; k < 2; ++k) { bf16x8 v = *(const LAS bf16x8*)(lds + Z_OFF + colp * ZSTRIDE + (32 * k + 8 * fq) * 2); if (!ok) v = (bf16x8){0, 0, 0, 0, 0, 0, 0, 0}; o[k] = v; }
        };
        const int d0 = ilo - (NBLK - 1);
        bf16x8 F[6], h0[2], h1[2], bn[2];
        getB(d0 - 2, h0); getB(d0 - 1, h1);
        F[4] = *(const LAS bf16x8*)(lds + abase - 32 * (4 * d0 - 2)); F[5] = *(const LAS bf16x8*)(lds + abase - 32 * (4 * d0 - 1));
#pragma unroll 2
        for (int d = d0; d <= ihi; ++d) {
            F[0] = F[4]; F[1] = F[5];
#pragma unroll
            for (int i = 2; i < 6; ++i) F[i] = *(const LAS bf16x8*)(lds + abase - 32 * (4 * d - 2 + i));
            getB(d, bn);
#pragma unroll
            for (int m = 0; m < 4; ++m) {
                acc[0][m] = __builtin_amdgcn_mfma_f32_16x16x32_bf16(F[m + 2], bn[0], acc[0][m], 0, 0, 0);
                acc[0][m] = __builtin_amdgcn_mfma_f32_16x16x32_bf16(F[m], bn[1], acc[0][m], 0, 0, 0);
                acc[1][m] = __builtin_amdgcn_mfma_f32_16x16x32_bf16(F[m + 2], h0[0], acc[1][m], 0, 0, 0);
                acc[1][m] = __builtin_amdgcn_mfma_f32_16x16x32_bf16(F[m], h0[1], acc[1][m], 0, 0, 0);
            }
            h0[0] = h1[0]; h0[1] = h1[1]; h1[0] = bn[0]; h1[1] = bn[1];
        }
    } else {
    for (int d = ilo - (NBLK - 1); d <= ihi; ++d) {
        bf16x8 af[MB][2];
#pragma unroll
        for (int m = 0; m < MB; ++m)
#pragma unroll
            for (int k = 0; k < 2; ++k) af[m][k] = *(const LAS bf16x8*)(lds + abase + 2 * (-64 * d - 16 * (mb0 + m) + 32 * k));
#pragma unroll
        for (int x = 0; x < CBW; ++x) {
            const int col = 16 * (cb0 + x) + fr, ip = (col >> 3) - d;
            const bool ok = (ip >= 0) && (ip < NBLK);
            const int colp = ok ? col - 8 * d : col;
            bf16x8 bfr[2];
#pragma unroll
            for (int k = 0; k < 2; ++k) {
                bf16x8 v = *(const LAS bf16x8*)(lds + Z_OFF + colp * ZSTRIDE + (32 * k + 8 * fq) * 2);
                if (!ok) v = (bf16x8){0, 0, 0, 0, 0, 0, 0, 0};
                bfr[k] = v;
            }
#pragma unroll
            for (int m = 0; m < MB; ++m)
#pragma unroll
                for (int k = 0; k < 2; ++k) acc[x][m] = __builtin_amdgcn_mfma_f32_16x16x32_bf16(af[m][k], bfr[k], acc[x][m], 0, 0, 0);
        }
    }
    }
    {
        const float w00 = cw[0 * 3072 + c], w01 = cw[1 * 3072 + c], w02 = cw[2 * 3072 + c], b0 = cb[c], fbias = p.in[22][c];
        const bf16_t* r0 = UT + (size_t)c * T_ALL + tok0;
#pragma unroll
        for (int x = 0; x < CBW; ++x)
#pragma unroll
            for (int m = 0; m < MB; ++m) {
                const int col = 16 * (cb0 + x) + fr, i = col >> 3, b = col & 7, r = 16 * (mb0 + m) + 4 * fq, t = 64 * i + r;
                const size_t o = (size_t)b * L + t;
                const u32x2 xr = *(const u32x2*)(r0 + o);
                float xv[6];
                xv[0] = t > 0 ? bf2f(r0[o - 1]) : 0.f; xv[5] = t + 4 < L ? bf2f(r0[o + 4]) : 0.f;
                xv[1] = bf2f(xr.x & 0xffffu); xv[2] = bf2f(xr.x >> 16); xv[3] = bf2f(xr.y & 0xffffu); xv[4] = bf2f(xr.y >> 16);
                const u32x2 zr = *(const LAS u32x2*)(lds + Z_OFF + col * ZSTRIDE + r * 2);
                const float zv[4] = {bf2f(zr.x & 0xffffu), bf2f(zr.x >> 16), bf2f(zr.y & 0xffffu), bf2f(zr.y >> 16)};
                float o4[4];
#pragma unroll
                for (int j = 0; j < 4; ++j) o4[j] = (b0 + w00 * xv[j] + w01 * xv[j + 1] + w02 * xv[j + 2]) * (acc[x][m][j] + fbias * zv[j]);
                u32x2 w; w.x = pack2(o4[0], o4[1]); w.y = pack2(o4[2], o4[3]);
                *(u32x2*)(YT + (size_t)c * T_ALL + tok0 + o) = w;
            }
    }
    __syncthreads();
}
__device__ __forceinline__ void longconv_phase(PARG p, LAS unsigned char* lds) {
    for (int c = blockIdx.x; c < DM; c += gridDim.x) longconv_channel<SEQ>(p, lds, c);
    for (int c = blockIdx.x; c < DM; c += gridDim.x) longconv_channel<CTXL>(p, lds, c);
}

__device__ __forceinline__ void transpose_phase(PARG p, LAS unsigned char* lds) {
    const bf16_t* S = (const bf16_t*)(p.ws + OFF_Y); bf16_t* Dst = (bf16_t*)(p.out);
    LAS bf16_t* t = (LAS bf16_t*)lds;
    const int tid = threadIdx.x;
    for (int item = blockIdx.x; item < 16 * (T_ALL / 64); item += gridDim.x) {
        const int c0 = (item & 15) * 64, t0 = (item >> 4) * 64;
        { const int c = tid >> 3, t8 = (tid & 7) * 8;
          *(LAS u32x4*)(t + c * 72 + t8) = *(const u32x4*)(S + (size_t)(c0 + c) * T_ALL + t0 + t8); }
        __syncthreads();
        { const int tt = tid >> 3, c8 = (tid & 7) * 8;
          unsigned v[8];
#pragma unroll
          for (int j = 0; j < 8; ++j) v[j] = t[(c8 + j) * 72 + tt];
          u32x4 w; w.x = v[0] | (v[1] << 16); w.y = v[2] | (v[3] << 16); w.z = v[4] | (v[5] << 16); w.w = v[6] | (v[7] << 16);
          *(u32x4*)(Dst + (size_t)(t0 + tt) * DM + c0 + c8) = w; }
        __syncthreads();
    }
}

__device__ __forceinline__ void rgconv_phase(PARG p) {
    const bf16_t* R = (const bf16_t*)(p.ws + OFF_BIG + 37748736); bf16_t* XC = (bf16_t*)(p.out);
    const float* cw = p.in[27]; const float* cb = p.in[28];
    for (int it = blockIdx.x * 512 + threadIdx.x; it < T_ALL * 128; it += gridDim.x * 512) {
        const int row = it >> 7, c8 = (it & 127) * 8;
        int t, L;
        if (row < T_LAT) { t = row & (SEQ - 1); L = SEQ; } else { t = (row - T_LAT) & (CTXL - 1); L = CTXL; }
        float o[8];
#pragma unroll
        for (int j = 0; j < 8; ++j) o[j] = cb[c8 + j];
#pragma unroll
        for (int k = 0; k < 4; ++k) {
            const int tt = t + k - 1;
            if (tt >= 0 && tt < L) {
                const u32x4 v = *(const u32x4*)(R + (size_t)(row + k - 1) * DM + c8);
                const f32x4 w0 = *(const f32x4*)(cw + k * DM + c8), w1 = *(const f32x4*)(cw + k * DM + c8 + 4);
#pragma unroll
                for (int j = 0; j < 4; ++j) { const float lo = bf2f(v[j] & 0xffffu), hi = bf2f(v[j] >> 16);
                    o[2 * j] += lo * (j < 2 ? w0[2 * j] : w1[2 * j - 4]); o[2 * j + 1] += hi * (j < 2 ? w0[2 * j + 1] : w1[2 * j - 3]); }
            }
        }
        u32x4 w; w.x = pack2(o[0], o[1]); w.y = pack2(o[2], o[3]); w.z = pack2(o[4], o[5]); w.w = pack2(o[6], o[7]);
        *(u32x4*)(XC + (size_t)row * DM + c8) = w;
    }
}

__device__ __forceinline__ int scan_row(int dir, int b, int q) {
    if (q < CTXL) return T_LAT + b * CTXL + (dir ? (CTXL - 1 - q) : q);
    const int t = q - CTXL; return b * SEQ + (dir ? (SEQ - 1 - t) : t);
}
__device__ __forceinline__ void scan_agg_phase(PARG p) {
    const unsigned* GA0 = (const unsigned*)(p.ws + OFF_BIG + 37748736); const unsigned* GA1 = (const unsigned*)(p.ws + OFF_EXTRA);
    f32x2* AGG = (f32x2*)(p.ws + OFF_Y);
    const int lane = threadIdx.x & 63, wv = threadIdx.x >> 6;
    for (int item = blockIdx.x * 8 + wv; item < 2 * 8 * 36 * 16; item += gridDim.x * 8) {
        const int cg_ = item & 15, k = (item >> 4) % 36, b = ((item >> 4) / 36) & 7, dir = (item >> 4) / 288;
        const int ch = cg_ * 64 + lane;
        const unsigned* GA = dir ? GA1 : GA0;
        const int r0 = scan_row(dir, b, 64 * k); const int step = dir ? -1 : 1;
        float A = 1.f, Bv = 0.f;
#pragma unroll 16
        for (int s = 0; s < 64; ++s) {
            const unsigned v = GA[(size_t)(r0 + step * s) * DM + ch];
            const float a = __expf(bf2f(v & 0xffffu)), bb = bf2f(v >> 16);
            A *= a; Bv = a * Bv + bb;
        }
        AGG[(((size_t)dir * 8 + b) * 36 + k) * DM + ch] = (f32x2){A, Bv};
    }
}
__device__ __forceinline__ void scan_out_phase(PARG p) {
    const unsigned* GA0 = (const unsigned*)(p.ws + OFF_BIG + 37748736); const unsigned* GA1 = (const unsigned*)(p.ws + OFF_EXTRA);
    const f32x2* AGG = (const f32x2*)(p.ws + OFF_Y);
    const bf16_t* G = (const bf16_t*)(p.ws + OFF_BIG);
    bf16_t* H = (bf16_t*)(p.out);
    const int lane = threadIdx.x & 63, wv = threadIdx.x >> 6;
    for (int item = blockIdx.x * 8 + wv; item < 8 * 32 * 16; item += gridDim.x * 8) {
        const int cg_ = item & 15, kl = (item >> 4) & 31, b = item >> 9;
        const int ch = cg_ * 64 + lane;
        float hf = 0.f, hr = 0.f;
        {
            const f32x2* ag0 = AGG + ((size_t)0 * 8 + b) * 36 * DM + ch; const int n0 = 4 + kl;
            const f32x2* ag1 = AGG + ((size_t)1 * 8 + b) * 36 * DM + ch; const int n1 = 4 + (31 - kl);
#pragma unroll 1
            for (int k0 = 0; k0 < 36; k0 += 12) {
                f32x2 v0[12], v1[12];
#pragma unroll
                for (int k = 0; k < 12; ++k) { v0[k] = (k0 + k < n0) ? ag0[(size_t)(k0 + k) * DM] : (f32x2){1.f, 0.f}; v1[k] = (k0 + k < n1) ? ag1[(size_t)(k0 + k) * DM] : (f32x2){1.f, 0.f}; }
#pragma unroll
                for (int k = 0; k < 12; ++k) { hf = v0[k].x * hf + v0[k].y; hr = v1[k].x * hr + v1[k].y; }
            }
            asm volatile("" ::: "memory");
        }
        const int row0 = b * SEQ + kl * 64;
        float hs[64];
#pragma unroll
        for (int s = 0; s < 64; ++s) {
            const unsigned v = GA0[(size_t)(row0 + s) * DM + ch];
            hf = __expf(bf2f(v & 0xffffu)) * hf + bf2f(v >> 16); hs[s] = hf;
        }
#pragma unroll
        for (int s = 63; s >= 0; --s) {
            const unsigned v = GA1[(size_t)(row0 + s) * DM + ch];
            hr = __expf(bf2f(v & 0xffffu)) * hr + bf2f(v >> 16);
            const float g = bf2f(G[(size_t)(row0 + s) * DM + ch]);
            H[(size_t)(row0 + s) * DM + ch] = (bf16_t)f2bf((hs[s] + hr) * geluf_(g));
        }
    }
}


#define XB_TMO      128
#define XB_XCNT(j)  (256  + 64 * (j))
#define XB_XSUB(j)  (1280 + 64 * (j))
#define XB_XGEN(j)  (2304 + 64 * (j))
#define XB_TOP      3328
#define XB_TOPGEN   3392
#define XCD_BAR_WORDS 3456
#define XB_SPIN_CAP (1u << 18)
__device__ __forceinline__ unsigned xb_ld(unsigned* p)              { return __hip_atomic_load(p, __ATOMIC_RELAXED, __HIP_MEMORY_SCOPE_AGENT); }
__device__ __forceinline__ unsigned xb_add(unsigned* p, unsigned v) { return __hip_atomic_fetch_add(p, v, __ATOMIC_RELAXED, __HIP_MEMORY_SCOPE_AGENT); }
__device__ __forceinline__ unsigned xb_xcc_id() { return (unsigned)__builtin_amdgcn_s_getreg((3 << 11) | 20) & 0xFu; }
#define XB_SPIN(cond, bar) do { unsigned _sp = 0; while (cond) { __builtin_amdgcn_s_sleep(1); \
    if ((++_sp & 255u) == 0u) { if (xb_ld(&(bar)[XB_TMO])) break; if (_sp > XB_SPIN_CAP) { atomicAdd(&(bar)[XB_TMO], 1u); break; } } } } while (0)
struct XcdBarrier { unsigned* bar; unsigned x; volatile LAS unsigned* st; };
__device__ __forceinline__ XcdBarrier xcd_barrier_post(unsigned* bar, volatile LAS unsigned* st) {
    XcdBarrier b; b.bar = bar; b.x = xb_xcc_id(); b.st = st;
    if (threadIdx.x == 0) (void)xb_add(&bar[XB_XCNT(b.x)], 1u);
    return b;
}
__device__ __forceinline__ void xcd_barrier_complete(unsigned* bar, unsigned x, unsigned& nloc, unsigned& nx) {
    const unsigned G = gridDim.x * gridDim.y * gridDim.z;
    unsigned sum, cnt, mine, sp = 0u;
    for (;;) {
        sum = 0u; cnt = 0u; mine = 0u;
#pragma unroll
        for (unsigned j = 0; j < 16; ++j) { const unsigned c = xb_ld(&bar[XB_XCNT(j)]); sum += c; cnt += (c > 0u) ? 1u : 0u; mine = (j == x) ? c : mine; }
        if (sum == G) break;
        __builtin_amdgcn_s_sleep(1);
        if ((++sp & 255u) == 0u) { if (xb_ld(&bar[XB_TMO])) break; if (sp > XB_SPIN_CAP) { atomicAdd(&bar[XB_TMO], 1u); break; } }
    }
    nloc = mine > 0u ? mine : 1u; nx = cnt > 0u ? cnt : 1u;
}
__device__ __forceinline__ void xcd_barrier(const XcdBarrier& b) {
    asm volatile("s_waitcnt vmcnt(0)" ::: "memory");
    __syncthreads();
    if (threadIdx.x == 0) {
        unsigned* bar = b.bar;
        __builtin_amdgcn_s_waitcnt(0);
        unsigned nloc = b.st[0], nx = b.st[1];
        if (nloc == 0u) { xcd_barrier_complete(bar, b.x, nloc, nx); b.st[0] = nloc; b.st[1] = nx; }
        const unsigned old = xb_add(&bar[XB_XSUB(b.x)], 1u);
        const unsigned gen = old / nloc;
        if (old + 1u == (gen + 1u) * nloc) {
            __builtin_amdgcn_fence(__ATOMIC_RELEASE, "agent");
            asm volatile("s_waitcnt vmcnt(0)" ::: "memory");
            const unsigned og = xb_add(&bar[XB_TOP], 1u);
            const unsigned tg = og / nx;
            if (og + 1u == (tg + 1u) * nx) xb_add(&bar[XB_TOPGEN], 1u);
            else XB_SPIN(xb_ld(&bar[XB_TOPGEN]) == tg, bar);
            __builtin_amdgcn_fence(__ATOMIC_ACQUIRE, "agent");
            xb_add(&bar[XB_XGEN(b.x)], 1u);
            asm volatile("s_waitcnt vmcnt(0)" ::: "memory");
        } else {
            XB_SPIN(xb_ld(&bar[XB_XGEN(b.x)]) == gen, bar);
            __builtin_amdgcn_fence(__ATOMIC_ACQUIRE, "agent");
            asm volatile("s_waitcnt vmcnt(0)" ::: "memory");
        }
    }
    __syncthreads();
}

__device__ __forceinline__ void run_gemm1(PARG p, LAS unsigned char* lds, int s, int M) {
    const bf16_t* W = (const bf16_t*)(p.ws + OFF_W);
    pg8::Gemm g{(const bf16_t*)(p.out), W + (s ? W_13_1 : W_13_0), M, 2 * FF, DM, DM, DM, 1 << 20, 0};
    pg8::StaticOrder S; S.init(T_LAT, g.N, g.K, gridDim.x, blockIdx.x, (M - T_LAT) / 256, 1);
    pg8::EpiSwiglu E{(bf16_t*)(p.ws + OFF_BIG)};
    pg8::gemm_phase(lds, g, S, E);
}
__device__ __forceinline__ void run_gemm2(PARG p, LAS unsigned char* lds, int s, int M) {
    const bf16_t* W = (const bf16_t*)(p.ws + OFF_W);
    pg8::Gemm g{(const bf16_t*)(p.ws + OFF_BIG), W + (s ? W_2_1 : W_2_0), M, DM, FF, FF, FF, 1 << 20, 0};
    pg8::StaticOrder S; S.init(T_LAT, g.N, g.K, gridDim.x, blockIdx.x, (M - T_LAT) / 256, 2);
    pg8::EpiBf16 E{(bf16_t*)(p.ws + OFF_Y), DM, nullptr, nullptr, 0, 0, (bf16_t*)(p.ws + OFF_YP)};
    pg8::gemm_phase(lds, g, S, E);
}

#ifndef PHSEL
#define PHSEL -1
#endif
__device__ __forceinline__ void run_phase(PARG p, LAS unsigned char* lds, int ph) {
    const bf16_t* W = (const bf16_t*)(p.ws + OFF_W);
    switch (ph) {
    case 0: if (PHSEL >= 0 && PHSEL != 0) break; ada_phase(p, lds); filter_phase(p, lds); convert_weights(p, lds, 0); break;
    case 1: if (PHSEL >= 0 && PHSEL != 1) break; ew_phase(p, EwArgs{1, 1, T_ALL, 0.f, 0, 0, 0, 0, 0, 0, 1, 1}); break;
    case 2: if (PHSEL >= 0 && PHSEL != 2) break; run_gemm1(p, lds, 0, T_ALL); break;
    case 3: if (PHSEL >= 0 && PHSEL != 3) break; run_gemm2(p, lds, 0, T_ALL); break;
    case 4: if (PHSEL >= 0 && PHSEL != 4) break; ew_phase(p, EwArgs{0, 1, T_ALL, 0.5f, 0, 2, 1, 0, 2, 3, 4, 2}); break;
    case 5: if (PHSEL >= 0 && PHSEL != 5) break; {
        pg8::Gemm g{W + W_HYIN, (const bf16_t*)(p.out), 3 * DM, T_ALL, DM, DM, DM, 1 << 20, 0};
        pg8::StaticOrder S; S.init(g.M, g.N, g.K, gridDim.x, blockIdx.x, 0, 1);
        pg8::EpiBf16 E{(bf16_t*)(p.ws + OFF_BIG), T_ALL, nullptr, p.in[11], 0, 0, nullptr};
        pg8::gemm_phase(lds, g, S, E);
    } break;
    case 6: if (PHSEL >= 0 && PHSEL != 6) break; longconv_phase(p, lds); break;
    case 7: if (PHSEL >= 0 && PHSEL != 7) break; transpose_phase(p, lds); break;
    case 8: if (PHSEL >= 0 && PHSEL != 8) break; {
        pg8::Gemm g{(const bf16_t*)(p.out), W + W_HYOUT, T_ALL, DM, DM, DM, DM, 1 << 20, 0};
        pg8::StaticOrder S; S.init(T_LAT, g.N, g.K, gridDim.x, blockIdx.x, 8, 4);
        pg8::EpiBf16 E{(bf16_t*)(p.ws + OFF_Y), DM, p.in[24], nullptr, 0, 0, (bf16_t*)(p.ws + OFF_YP)};
        pg8::gemm_phase(lds, g, S, E);
    } break;
    case 9: if (PHSEL >= 0 && PHSEL != 9) break; ew_phase(p, EwArgs{0, 1, T_ALL, 1.0f, 0, 5, 3, 0, 4, 6, 7, 4}); break;
    case 10: if (PHSEL >= 0 && PHSEL != 10) break; run_gemm1(p, lds, 1, T_ALL); break;
    case 11: if (PHSEL >= 0 && PHSEL != 11) break; run_gemm2(p, lds, 1, T_ALL); break;
    case 12: if (PHSEL >= 0 && PHSEL != 12) break; ew_phase(p, EwArgs{0, 1, T_ALL, 0.5f, 0, 8, 5, 1, 0, 0, 1, 2}); convert_weights(p, lds, 1);
        if (blockIdx.x == gridDim.x - 1) for (int i = threadIdx.x; i < 2 * DM; i += 512) ((float*)(p.ws + OFF_SP8))[i] = -8.0f * log1pf(__expf(-p.in[33][i]));
        break;
    case 13: if (PHSEL >= 0 && PHSEL != 13) break; run_gemm1(p, lds, 0, T_ALL); break;
    case 14: if (PHSEL >= 0 && PHSEL != 14) break; run_gemm2(p, lds, 0, T_ALL); break;
    case 15: if (PHSEL >= 0 && PHSEL != 15) break; ew_phase(p, EwArgs{0, 1, T_ALL, 0.5f, 1, 2, 1, 1, 2, 3, 4, 2}); break;
    case 16: if (PHSEL >= 0 && PHSEL != 16) break; {
        pg8::Gemm g{(const bf16_t*)(p.out), W + W_RGIN, T_ALL, 2 * DM, DM, DM, DM, 1 << 20, 0};
        pg8::StaticOrder S; S.init(T_LAT, g.N, g.K, gridDim.x, blockIdx.x, 8, 1);
        pg8::EpiBf16 E{(bf16_t*)(p.ws + OFF_BIG), DM, p.in[26], nullptr, DM, (size_t)T_ALL * DM, nullptr};
        pg8::gemm_phase(lds, g, S, E);
    } break;
    case 17: if (PHSEL >= 0 && PHSEL != 17) break; rgconv_phase(p); break;
    case 18: if (PHSEL >= 0 && PHSEL != 18) break; {
        pg8::Gemm g{(const bf16_t*)(p.out), W + W_GATE, T_ALL, 4096, 256, DM, 256, 4, 256};
        pg8::StaticOrder S; S.init(T_LAT, g.N, g.K, gridDim.x, blockIdx.x, 8, 1);
        pg8::EpiGate E{(unsigned*)(p.ws + OFF_BIG + 37748736), (unsigned*)(p.ws + OFF_EXTRA), (const bf16_t*)(p.out), p.in[30], p.in[32], (const float*)(p.ws + OFF_SP8), (f32x2*)(p.ws + OFF_Y)};
        pg8::gemm_phase(lds, g, S, E);
    } break;
    case 19: break;
    case 20: if (PHSEL >= 0 && PHSEL != 20) break; scan_out_phase(p); break;
    case 21: if (PHSEL >= 0 && PHSEL != 21) break; {
        pg8::Gemm g{(const bf16_t*)(p.out), W + W_RGOUT, T_LAT, DM, DM, DM, DM, 1 << 20, 0};
        pg8::StaticOrder S; S.init(T_LAT, g.N, g.K, gridDim.x, blockIdx.x, 0, 1);
        pg8::EpiBf16 E{(bf16_t*)(p.ws + OFF_Y), DM, p.in[35], nullptr, 0, 0, nullptr};
        pg8::gemm_phase(lds, g, S, E);
    } break;
    case 22: if (PHSEL >= 0 && PHSEL != 22) break; ew_phase(p, EwArgs{0, 1, T_LAT, 1.0f, 1, 5, 3, 1, 4, 6, 7, 1}); break;
    case 23: if (PHSEL >= 0 && PHSEL != 23) break; run_gemm1(p, lds, 1, T_LAT); break;
    case 24: if (PHSEL >= 0 && PHSEL != 24) break; run_gemm2(p, lds, 1, T_LAT); break;
    case 25: if (PHSEL >= 0 && PHSEL != 25) break; ew_phase(p, EwArgs{0, 0, T_LAT, 0.5f, 1, 8, 5, 0, 0, 0, 0, 1}); break;
    default: break;
    }
}

__global__ void __launch_bounds__(512, 2) mega_kernel(Params p) {
    extern __shared__ __attribute__((aligned(16))) unsigned char shm[];
    LAS unsigned char* lds = (LAS unsigned char*)shm;
    cg::grid_group grid = cg::this_grid();
    typedef const __attribute__((address_space(4))) Params* KP;
    const KP kp = (KP)__builtin_amdgcn_kernarg_segment_ptr();
    volatile LAS unsigned* st = (volatile LAS unsigned*)(lds + LDS_MAIN);
    if (threadIdx.x == 0) { st[0] = 0u; st[1] = 0u; }
    __syncthreads();
    XcdBarrier xb; xb.bar = nullptr; xb.x = 0; xb.st = st;
    if (kp->ph_hi - kp->ph_lo > 1) xb = xcd_barrier_post((unsigned*)(kp->ws + OFF_BAR), st);
    if (kp->ph_hi > 4096) grid.sync();
#define PH(k) { KP q = kp; asm volatile("" : "+s"(q)); const int lo_ = q->ph_lo, hi_ = q->ph_hi; if (lo_ <= (k) && (k) < hi_) { run_phase(*q, lds, (k)); if ((REPEAT_MASK >> (k)) & 1u) { xcd_barrier(xb); run_phase(*q, lds, (k)); } if ((k) + 1 < hi_) xcd_barrier(xb); } }
    PH(0) PH(1) PH(2) PH(3) PH(4) PH(5) PH(6) PH(7) PH(8) PH(9) PH(10) PH(11) PH(12) PH(13) PH(14) PH(15) PH(16) PH(17) PH(18) PH(20) PH(21) PH(22) PH(23) PH(24) PH(25)
#undef PH
}

#ifndef N_LAUNCH_MODE
#define N_LAUNCH_MODE 0
#endif

extern "C" void kernel_launch(void* const* d_in, const int* in_sizes, int n_in, void* d_out, int out_size, void* d_ws, size_t ws_size, hipStream_t stream) {
    static int grid = 0;
    if (grid == 0) {
        if (n_in != 36 || ws_size < WS_END) { fprintf(stderr, "kernel_launch: unexpected n_in %d / ws_size %zu (need %zu)\n", n_in, ws_size, (size_t)WS_END); grid = -1; return; }
        int dev = 0, cus = 0, per_cu = 0;
        hipGetDevice(&dev);
        hipDeviceGetAttribute(&cus, hipDeviceAttributeMultiprocessorCount, dev);
        if (hipFuncSetAttribute((const void*)mega_kernel, hipFuncAttributeMaxDynamicSharedMemorySize, LDS_BYTES) != hipSuccess) { fprintf(stderr, "hipFuncSetAttribute failed\n"); grid = -1; return; }
        if (hipOccupancyMaxActiveBlocksPerMultiprocessor(&per_cu, (const void*)mega_kernel, 512, LDS_BYTES) != hipSuccess || per_cu < 1) { fprintf(stderr, "occupancy query: %d\n", per_cu); per_cu = 1; }
        (void)hipGetLastError();
        grid = cus * 1;
    }
    if (grid < 0) return;
    Params p{};
    for (int i = 0; i < 36; ++i) p.in[i] = (const float*)d_in[i];
    p.out = (float*)d_out; p.ws = (unsigned char*)d_ws;
#if N_LAUNCH_MODE == 1
    for (int ph = 0; ph < NPHASE; ++ph) {
        p.ph_lo = ph; p.ph_hi = ph + 1;
        hipLaunchKernelGGL(mega_kernel, dim3(grid), dim3(512), LDS_BYTES, stream, p);
    }
#else
    p.ph_lo = 0; p.ph_hi = NPHASE;
    if (hipMemsetAsync((unsigned char*)d_ws + OFF_BAR, 0, XCD_BAR_WORDS * 4, stream) != hipSuccess) { fprintf(stderr, "memset failed\n"); return; }
    void* args[] = {&p};
    hipError_t e = hipLaunchCooperativeKernel((const void*)mega_kernel, dim3(grid), dim3(512), args, LDS_BYTES, stream);
    if (e != hipSuccess) fprintf(stderr, "cooperative launch failed: %s (grid %d)\n", hipGetErrorString(e), grid);
#endif
}
```

```cpp
#include <hip/hip_runtime.h>
#include <hip/hip_cooperative_groups.h>
#include <cstdio>
#include <cstdint>
namespace cg = cooperative_groups;

#define LAS __attribute__((address_space(3)))
typedef unsigned short bf16_t;
typedef short bf16x8 __attribute__((ext_vector_type(8)));
typedef float f32x4 __attribute__((ext_vector_type(4)));
typedef float f32x2 __attribute__((ext_vector_type(2)));
typedef unsigned u32x4 __attribute__((ext_vector_type(4)));
typedef unsigned u32x2 __attribute__((ext_vector_type(2)));

constexpr int T_ALL = 18432, T_LAT = 16384, DM = 1024, FF = 2816, SEQ = 2048, CTXL = 256, NB = 8;
constexpr int LDS_MAIN = 131072;
constexpr int LDS_BYTES = LDS_MAIN + 16;
constexpr int NPHASE = 26;
#define REPEAT_MASK 0u
constexpr size_t OFF_XS = 0;
constexpr size_t OFF_Y = OFF_XS + 8388608;
constexpr size_t OFF_H = OFF_Y + 37748736;
constexpr size_t OFF_BIG = OFF_H + 37748736;
constexpr size_t OFF_W = OFF_BIG + 113246208;
constexpr size_t OFF_MOD = OFF_W + 42991616;
constexpr size_t OFF_EXTRA = OFF_MOD + 663552;
constexpr size_t OFF_SP8 = OFF_EXTRA + 75497472;
constexpr size_t OFF_BAR = OFF_SP8 + 8192;
constexpr size_t WS_END = OFF_BAR + 16384;
constexpr size_t W_13_0 = 0, W_2_0 = 5767168, W_13_1 = 8650752, W_2_1 = 14417920, W_MIX = 17301504;
constexpr size_t W_HYIN = W_MIX, W_HYOUT = W_MIX + 3145728;
constexpr size_t W_RGIN = W_MIX, W_GATE = W_MIX + 2097152, W_RGOUT = W_MIX + 3145728;
constexpr size_t OFF_FILT = OFF_EXTRA;
constexpr size_t OFF_FILTC = OFF_EXTRA + 8388608;
constexpr size_t OFF_YP = OFF_EXTRA + 16777216;

#define PARG const __attribute__((address_space(4))) Params&
struct Params { const float* in[36]; float* out; unsigned char* ws; int ph_lo, ph_hi; };

__device__ __forceinline__ float bf2f(unsigned v) { return __uint_as_float(v << 16); }
__device__ __forceinline__ unsigned f2bf(float f) { unsigned u = __float_as_uint(f); u += 0x7FFFu + ((u >> 16) & 1u); return u >> 16; }
__device__ __forceinline__ unsigned pack2(float lo, float hi) { return f2bf(lo) | (f2bf(hi) << 16); }
__device__ __forceinline__ unsigned cvt_pk_bf16(float lo, float hi) { unsigned r; asm volatile("v_cvt_pk_bf16_f32 %0, %1, %2" : "=v"(r) : "v"(lo), "v"(hi)); return r; }
__device__ __forceinline__ float sigmoidf_(float x) { return __builtin_amdgcn_rcpf(1.0f + __expf(-x)); }
__device__ __forceinline__ float siluf_(float x) { return x * __builtin_amdgcn_rcpf(1.0f + __expf(-x)); }
__device__ __forceinline__ float geluf_(float x) { const float u = 0.7978845608f * (x + 0.044715f * x * x * x); const float e = __expf(2.0f * u); const float t = 1.0f - 2.0f * __builtin_amdgcn_rcpf(e + 1.0f); return 0.5f * x * (1.0f + t); }
__device__ __forceinline__ float wave_sum(float v) {
#pragma unroll
    for (int o = 32; o > 0; o >>= 1) v += __shfl_xor(v, o, 64);
    return v;
}

namespace pg8 {
constexpr int BM = 256, BK = 64, HALF = 128, HTB = HALF * BK * 2, NXCD = 8, WGM = 8;
__host__ __device__ __forceinline__ int lds_byte(int r, int c) { const int st = (r >> 4) * 2 + (c >> 5), rr = r & 15, cc = c & 31, ob = rr * 64 + cc * 2; return st * 1024 + (ob ^ (((ob >> 9) & 1) << 5)); }
__host__ __device__ __forceinline__ void stage_rc(int b, int& R, int& C) { const int st = b / 1024, sb = b % 1024, swz = sb ^ (((sb >> 9) & 1) << 5); R = (st >> 1) * 16 + swz / 64; C = (st & 1) * 32 + (swz % 64) / 2; }
__host__ __device__ __forceinline__ int perm32(int rho) { const int n = rho >> 4, i = rho & 15; return 8 * (i >> 2) + 4 * n + (i & 3); }
struct Unit { int pm, pn, ks, nt, koff; };
struct Gemm { const bf16_t* A; const bf16_t* Bt; int M, N, K, lda, ldb, agrp, agoff; };
struct StaticOrder {
    int nM, nN, nwg, G, c, nctx, KS, ntt;
    __device__ void init(int M_main, int N, int K, int G_, int c_, int ctx_panels, int ks_) { nM = M_main / BM; nN = N / BM; nwg = nM * nN; G = G_; c = c_; nctx = ctx_panels; KS = ks_; ntt = K / BK; }
    __device__ bool next(int i, Unit& u) const {
        const long L = (long)i * G + c;
        if (L >= nwg) {
            int e = (int)(L - nwg); if (e >= nctx * nN * KS) return false;
            u.ks = e % KS; e /= KS; u.pn = e % nN; u.pm = 64 + e / nN; u.nt = ntt / KS; u.koff = u.ks * u.nt * BK; return true;
        }
        int wgid = (int)L; { const int q = nwg / NXCD, r = nwg % NXCD, xcd = wgid % NXCD, off = wgid / NXCD; wgid = (xcd < r ? xcd * (q + 1) : r * (q + 1) + (xcd - r) * q) + off; }
        const int nig = WGM * nN, gid = wgid / nig, fm = gid * WGM, gsz = (nM - fm) < WGM ? (nM - fm) : WGM;
        u.pm = fm + ((wgid % nig) % gsz); u.pn = (wgid % nig) / gsz; u.ks = 0; u.nt = ntt; u.koff = 0; return true;
    }
};

template <class Epi>
__device__ __forceinline__ void gemm_phase(LAS unsigned char* lds, const Gemm g, const StaticOrder& S, const Epi& E) {
    const int tid = threadIdx.x, wid = __builtin_amdgcn_readfirstlane(tid >> 6), lane = tid & 63, wr = wid >> 2, wc = wid & 3, fr = lane & 15, fq = lane >> 4;
    unsigned voffA[2], voffB[2];
#pragma unroll
    for (int i = 0; i < 2; ++i) { int R, C; stage_rc(tid * 16 + i * 8192, R, C); const int Rb = Epi::PERM ? ((R & ~31) + perm32(R & 31)) : R;
        voffA[i] = (unsigned)(R * g.lda + C) * 2u; voffB[i] = (unsigned)(Rb * g.ldb + C) * 2u; }
    const size_t kstep = (size_t)(BK * 2);
    const size_t hstepA = (size_t)HALF * g.lda * 2, hstepB = (size_t)HALF * g.ldb * 2;
    const size_t tstepA = 2 * hstepA, tstepB = 2 * hstepB;
    const unsigned ldsw = (unsigned)wid * 1024u;
    const int aoff = lds_byte(wr * 64 + fr, fq * 8), boff = lds_byte(wc * 32 + fr, fq * 8);
#define PG8_SA(b, h) (((b) * 2 + (h)) * HTB)
#define PG8_SB(b, h) ((4 + (b) * 2 + (h)) * HTB)
#define PG8_STAGE(bufoff, gbase, voff) do { _Pragma("unroll") for (int _i = 0; _i < 2; ++_i) \
        __builtin_amdgcn_global_load_lds((const unsigned*)((const char*)(gbase) + (voff)[_i]), (LAS unsigned*)(lds + (bufoff) + ldsw + _i * 8192), 16, 0, 0); } while (0)
#define PG8_LDA(dst, b, h) do { _Pragma("unroll") for (int m = 0; m < 4; ++m) _Pragma("unroll") for (int k = 0; k < 2; ++k) dst[m][k] = *(const LAS bf16x8*)(lds + PG8_SA(b, h) + aoff + m * 2048 + k * 1024); } while (0)
#define PG8_LDB(dst, b, h) do { _Pragma("unroll") for (int n = 0; n < 2; ++n) _Pragma("unroll") for (int k = 0; k < 2; ++k) dst[n][k] = *(const LAS bf16x8*)(lds + PG8_SB(b, h) + boff + n * 2048 + k * 1024); } while (0)
#define PG8_MMA(ai, bj, At, Bt) do { __builtin_amdgcn_s_setprio(1); _Pragma("unroll") for (int m = 0; m < 4; ++m) _Pragma("unroll") for (int n = 0; n < 2; ++n) _Pragma("unroll") for (int k = 0; k < 2; ++k) \
        acc[ai][bj][m][n] = __builtin_amdgcn_mfma_f32_16x16x32_bf16(Bt[n][k], At[m][k], acc[ai][bj][m][n], 0, 0, 0); __builtin_amdgcn_s_setprio(0); } while (0)
#define PG8_WAIT_V(n) asm volatile("s_waitcnt vmcnt(" #n ")" ::: "memory")
#define PG8_WAIT_L(n) asm volatile("s_waitcnt lgkmcnt(" #n ")" ::: "memory")
#define PG8_BAR __builtin_amdgcn_s_barrier()
#define PG8_SCHED __builtin_amdgcn_sched_barrier(0)
#define PG8_UA(u) ((const char*)g.A + (size_t)(u).pm * tstepA + (size_t)((u).pn / g.agrp) * (size_t)g.agoff * 2 + (size_t)(u).koff * 2)
#define PG8_UB(u) ((const char*)g.Bt + (size_t)(u).pn * tstepB + (size_t)(u).koff * 2)
    Unit cur, nxt; int ui = 0;
    if (!S.next(0, cur)) return;
    f32x4 acc[2][2][4][2];
#pragma unroll
    for (int a = 0; a < 2; ++a)
#pragma unroll
        for (int b = 0; b < 2; ++b)
#pragma unroll
            for (int m = 0; m < 4; ++m)
#pragma unroll
                for (int n = 0; n < 2; ++n) acc[a][b][m][n] = (f32x4){0.f, 0.f, 0.f, 0.f};
    bf16x8 At[4][2], B0[2][2], B1[2][2];
    const char* cA = PG8_UA(cur); const char* cB = PG8_UB(cur);
    PG8_STAGE(PG8_SB(0, 0), cB, voffB); PG8_STAGE(PG8_SA(0, 0), cA, voffA); PG8_STAGE(PG8_SB(0, 1), cB + hstepB, voffB); PG8_STAGE(PG8_SA(0, 1), cA + hstepA, voffA);
    if (wr == 1) PG8_BAR;
    PG8_WAIT_V(4); PG8_BAR;
    PG8_STAGE(PG8_SB(1, 0), cB + kstep, voffB); PG8_STAGE(PG8_SA(1, 0), cA + kstep, voffA); PG8_STAGE(PG8_SB(1, 1), cB + hstepB + kstep, voffB);
    PG8_WAIT_V(6); PG8_BAR;
    for (;;) {
        const bool has_next = S.next(ui + 1, nxt);
        const char* nA = has_next ? PG8_UA(nxt) : cA; const char* nB = has_next ? PG8_UB(nxt) : cB;
        const int nt = cur.nt;
        for (int t = 0; t < nt; t += 2) {
            const bool last = (t == nt - 2);
            const char* a1 = cA + (size_t)(t + 1) * kstep;
            const char* a2 = last ? nA : cA + (size_t)(t + 2) * kstep; const char* b2 = last ? nB : cB + (size_t)(t + 2) * kstep;
            const char* a3 = a2 + kstep; const char* b3 = b2 + kstep;
            PG8_LDB(B0, 0, 0); PG8_SCHED; PG8_LDA(At, 0, 0); PG8_STAGE(PG8_SA(1, 1), a1 + hstepA, voffA);
            PG8_WAIT_L(8); PG8_BAR; PG8_WAIT_L(0); PG8_MMA(0, 0, At, B0); PG8_BAR; PG8_SCHED;
            PG8_LDB(B1, 0, 1); PG8_STAGE(PG8_SB(0, 0), b2, voffB);
            PG8_BAR; PG8_WAIT_L(0); PG8_MMA(0, 1, At, B1); PG8_BAR;
            PG8_LDA(At, 0, 1); PG8_STAGE(PG8_SA(0, 0), a2, voffA);
            PG8_BAR; PG8_WAIT_L(0); PG8_MMA(1, 0, At, B0); PG8_BAR; PG8_SCHED;
            PG8_STAGE(PG8_SB(0, 1), b2 + hstepB, voffB);
            PG8_WAIT_V(6); PG8_BAR; PG8_MMA(1, 1, At, B1); PG8_BAR;
            PG8_LDB(B0, 1, 0); PG8_SCHED; PG8_LDA(At, 1, 0); PG8_STAGE(PG8_SA(0, 1), a2 + hstepA, voffA);
            PG8_WAIT_L(8); PG8_BAR; PG8_WAIT_L(0); PG8_MMA(0, 0, At, B0); PG8_BAR; PG8_SCHED;
            PG8_LDB(B1, 1, 1); PG8_STAGE(PG8_SB(1, 0), b3, voffB);
            PG8_BAR; PG8_WAIT_L(0); PG8_MMA(0, 1, At, B1); PG8_BAR;
            PG8_LDA(At, 1, 1); PG8_STAGE(PG8_SA(1, 0), a3, voffA);
            PG8_BAR; PG8_WAIT_L(0); PG8_MMA(1, 0, At, B0); PG8_BAR; PG8_SCHED;
            PG8_STAGE(PG8_SB(1, 1), b3 + hstepB, voffB);
            PG8_WAIT_V(6); PG8_BAR; PG8_MMA(1, 1, At, B1); PG8_BAR;
        }
        E(acc, cur, wr, wc, fr, fq);
        if (!has_next) break;
#pragma unroll
        for (int a = 0; a < 2; ++a)
#pragma unroll
            for (int b = 0; b < 2; ++b)
#pragma unroll
                for (int m = 0; m < 4; ++m)
#pragma unroll
                    for (int n = 0; n < 2; ++n) acc[a][b][m][n] = (f32x4){0.f, 0.f, 0.f, 0.f};
        cur = nxt; cA = nA; cB = nB; ++ui;
    }
    PG8_WAIT_V(0);
    if (wr == 0) PG8_BAR;
    PG8_BAR;
#undef PG8_SA
#undef PG8_SB
#undef PG8_STAGE
#undef PG8_LDA
#undef PG8_LDB
#undef PG8_MMA
#undef PG8_WAIT_V
#undef PG8_WAIT_L
#undef PG8_BAR
#undef PG8_SCHED
#undef PG8_UA
#undef PG8_UB
}

struct EpiSwiglu {
    static constexpr bool PERM = true;
    bf16_t* O;
    __device__ __forceinline__ void operator()(const f32x4 (&acc)[2][2][4][2], const Unit& u, int wr, int wc, int fr, int fq) const {
        const int row0 = u.pm * BM + wr * 64 + fr, col0 = u.pn * 128 + wc * 32 + 8 * fq;
#pragma unroll
        for (int ai = 0; ai < 2; ++ai)
#pragma unroll
            for (int m = 0; m < 4; ++m) {
                bf16_t* rowp = O + (size_t)(row0 + ai * HALF + m * 16) * FF + col0;
                float v[8];
#pragma unroll
                for (int n = 0; n < 2; ++n)
#pragma unroll
                    for (int j = 0; j < 4; ++j) v[n * 4 + j] = siluf_(acc[ai][0][m][n][j]) * acc[ai][1][m][n][j];
                u32x4 w; w.x = cvt_pk_bf16(v[0], v[1]); w.y = cvt_pk_bf16(v[2], v[3]); w.z = cvt_pk_bf16(v[4], v[5]); w.w = cvt_pk_bf16(v[6], v[7]);
                *(u32x4*)rowp = w;
            }
    }
};
struct EpiBf16 {
    static constexpr bool PERM = true;
    bf16_t* O; int ldc; const float* cbias; const float* rbias; int split_cols; size_t split_stride; bf16_t* P;
    __device__ __forceinline__ void operator()(const f32x4 (&acc)[2][2][4][2], const Unit& u, int wr, int wc, int fr, int fq) const {
        const int row0 = u.pm * BM + wr * 64 + fr; int colt = u.pn * BM; bf16_t* base = O;
        const bool part = u.ks > 0;
        if (part) base = P + (size_t)(u.ks - 1) * (2048 * DM) - (size_t)T_LAT * ldc;
        if (split_cols) { const int t = colt / split_cols; base += (size_t)t * split_stride; colt -= t * split_cols; }
        const int col0 = colt + wc * 32 + 8 * fq, bcol0 = u.pn * BM + wc * 32 + 8 * fq;
        f32x4 bv[2][2];
#pragma unroll
        for (int bj = 0; bj < 2; ++bj)
#pragma unroll
            for (int n = 0; n < 2; ++n) bv[bj][n] = (cbias && !part) ? *(const f32x4*)(cbias + bcol0 + bj * HALF + 4 * n) : (f32x4){0.f, 0.f, 0.f, 0.f};
#pragma unroll
        for (int ai = 0; ai < 2; ++ai)
#pragma unroll
            for (int m = 0; m < 4; ++m) {
                const int row = row0 + ai * HALF + m * 16;
                const float rb = rbias ? rbias[row] : 0.f;
                bf16_t* rowp = base + (size_t)row * ldc + col0;
#pragma unroll
                for (int bj = 0; bj < 2; ++bj) { f32x4 v0 = acc[ai][bj][m][0] + bv[bj][0] + rb, v1 = acc[ai][bj][m][1] + bv[bj][1] + rb;
                    u32x4 w; w.x = cvt_pk_bf16(v0[0], v0[1]); w.y = cvt_pk_bf16(v0[2], v0[3]); w.z = cvt_pk_bf16(v1[0], v1[1]); w.w = cvt_pk_bf16(v1[2], v1[3]);
                    *(u32x4*)(rowp + bj * HALF) = w; }
            }
    }
};
__device__ __forceinline__ float dpp_shr(float oldv, float v, int sh) {
    int r;
    switch (sh) {
    case 1: r = __builtin_amdgcn_update_dpp(__float_as_int(oldv), __float_as_int(v), 0x111, 0xf, 0xf, false); break;
    case 2: r = __builtin_amdgcn_update_dpp(__float_as_int(oldv), __float_as_int(v), 0x112, 0xf, 0xf, false); break;
    case 4: r = __builtin_amdgcn_update_dpp(__float_as_int(oldv), __float_as_int(v), 0x114, 0xf, 0xf, false); break;
    default: r = __builtin_amdgcn_update_dpp(__float_as_int(oldv), __float_as_int(v), 0x118, 0xf, 0xf, false); break;
    }
    return __int_as_float(r);
}
__device__ __forceinline__ float dpp_shl(float oldv, float v, int sh) {
    int r;
    switch (sh) {
    case 1: r = __builtin_amdgcn_update_dpp(__float_as_int(oldv), __float_as_int(v), 0x101, 0xf, 0xf, false); break;
    case 2: r = __builtin_amdgcn_update_dpp(__float_as_int(oldv), __float_as_int(v), 0x102, 0xf, 0xf, false); break;
    case 4: r = __builtin_amdgcn_update_dpp(__float_as_int(oldv), __float_as_int(v), 0x104, 0xf, 0xf, false); break;
    default: r = __builtin_amdgcn_update_dpp(__float_as_int(oldv), __float_as_int(v), 0x108, 0xf, 0xf, false); break;
    }
    return __int_as_float(r);
}
struct EpiGate {
    static constexpr bool PERM = false;
    unsigned* GA0; unsigned* GA1; const bf16_t* XC; const float* ba; const float* bi; const float* lam; f32x2* AGG;
    __device__ __forceinline__ void operator()(const f32x4 (&acc)[2][2][4][2], const Unit& u, int wr, int wc, int fr, int fq) const {
        const int row0 = u.pm * BM + wr * 64 + fr;
        const int ch0 = (u.pn >> 2) * 256 + (u.pn & 3) * 64 + wc * 16 + fq * 4;
        const bool isctx = u.pm >= 64;
        const int bseq = isctx ? (u.pm - 64) : (u.pm >> 3);
#pragma unroll
        for (int d = 0; d < 2; ++d) {
            unsigned* GA = d ? GA1 : GA0;
#pragma unroll
            for (int ai = 0; ai < 2; ++ai) {
                float Aq[4], Bq[4];
#pragma unroll
                for (int j = 0; j < 4; ++j) { Aq[j] = 1.f; Bq[j] = 0.f; }
#pragma unroll
                for (int m0 = 0; m0 < 4; ++m0) {
                    const int m = d ? 3 - m0 : m0;
                    const int row = row0 + ai * HALF + m * 16;
                    const f32x4 bav = *(const f32x4*)(ba + d * DM + ch0), biv = *(const f32x4*)(bi + d * DM + ch0), spv = *(const f32x4*)(lam + d * DM + ch0);
                    const u32x2 xr = *(const u32x2*)(XC + (size_t)row * DM + ch0);
                    const float xc[4] = {bf2f(xr.x & 0xffffu), bf2f(xr.x >> 16), bf2f(xr.y & 0xffffu), bf2f(xr.y >> 16)};
                    u32x4 w; float av[4];
#pragma unroll
                    for (int j = 0; j < 4; ++j) {
                        const float rr = sigmoidf_(acc[ai][d][m][0][j] + bav[j]);
                        const float ii = sigmoidf_(acc[ai][d][m][1][j] + biv[j]);
                        const float la = rr * spv[j];
                        const float ar = __expf(bf2f(cvt_pk_bf16(la, 0.f) & 0xffffu));
                        av[j] = ar;
                        const float bb = __builtin_amdgcn_sqrtf(fmaxf(1.0f - ar * ar, 0.f)) * ii * xc[j];
                        w[j] = cvt_pk_bf16(la, bb);
                    }
                    *(u32x4*)(GA + (size_t)row * DM + ch0) = w;
#pragma unroll
                    for (int j = 0; j < 4; ++j) {
                        float a = av[j], b = bf2f(w[j] >> 16);
#pragma unroll
                        for (int sh = 1; sh < 16; sh <<= 1) {
                            const float ap = d ? dpp_shl(1.f, a, sh) : dpp_shr(1.f, a, sh);
                            const float bp = d ? dpp_shl(0.f, b, sh) : dpp_shr(0.f, b, sh);
                            b = a * bp + b; a = a * ap;
                        }
                        Bq[j] = a * Bq[j] + b; Aq[j] = a * Aq[j];
                    }
                    asm volatile("" ::: "memory");
                }
                if (fr == (d ? 0 : 15)) {
                    const int c64 = 2 * ai + wr;
                    int k;
                    if (isctx) k = d ? 3 - c64 : c64;
                    else { const int kl = (u.pm & 7) * 4 + c64; k = 4 + (d ? 31 - kl : kl); }
                    f32x2* dst = AGG + (((size_t)d * 8 + bseq) * 36 + k) * DM + ch0;
                    *(f32x4*)dst = (f32x4){Aq[0], Bq[0], Aq[1], Bq[1]};
                    *(f32x4*)(dst + 2) = (f32x4){Aq[2], Bq[2], Aq[3], Bq[3]};
                }
            }
        }
    }
};
}

__device__ __forceinline__ void convT_tile(LAS unsigned char* lds, const float* src, int N, int K, bf16_t* dst, int mode, int aux, int tile) {
    LAS float* t = (LAS float*)lds;
    const int ntn = N / 256, tk = tile / ntn, tn = tile % ntn, k0 = tk * 64, n0 = tn * 256, tid = threadIdx.x;
    {
        const int kk = tid >> 6, n4 = (tid & 63) * 4;
        f32x4 v[8];
#pragma unroll
        for (int i = 0; i < 8; ++i) v[i] = *(const f32x4*)(src + (size_t)(k0 + kk + 8 * i) * N + n0 + n4);
#pragma unroll
        for (int i = 0; i < 8; ++i)
#pragma unroll
            for (int j = 0; j < 4; ++j) t[(kk + 8 * i) * 257 + n4 + j] = v[i][j];
    }
    __syncthreads();
#pragma unroll
    for (int i = 0; i < 4; ++i) {
        const int pi = tid + 512 * i, n = pi >> 3, k8 = (pi & 7) * 8, ng = n0 + n;
        int row;
        if (mode == 0) row = ng;
        else if (mode == 1) row = (ng >> 7) * 256 + (ng & 127);
        else if (mode == 2) row = (ng >> 7) * 256 + 128 + (ng & 127);
        else { const int d = aux & 1, gate = (aux >> 1) & 1, h = aux >> 2; const int pn = 4 * h + (ng >> 6), q = ng & 63;
               row = 256 * pn + 128 * d + 32 * (q >> 4) + 16 * gate + (q & 15); }
        float v[8];
#pragma unroll
        for (int j = 0; j < 8; ++j) v[j] = t[(k8 + j) * 257 + n];
        u32x4 w; w.x = pack2(v[0], v[1]); w.y = pack2(v[2], v[3]); w.z = pack2(v[4], v[5]); w.w = pack2(v[6], v[7]);
        *(u32x4*)(dst + (size_t)row * K + k0 + k8) = w;
    }
    __syncthreads();
}

__device__ __forceinline__ int conv_items(PARG p, LAS unsigned char* lds, int layer, int set, int tile) {
    bf16_t* W = (bf16_t*)(p.ws + OFF_W);
    int base = 0;
#define CONV_MAT(SRC, NN, KK, DST, MODE, AUX) { const int cnt = ((NN) / 256) * ((KK) / 64); if (tile >= base && tile < base + cnt) { convT_tile(lds, (SRC), (NN), (KK), (DST), (MODE), (AUX), tile - base); return -1; } base += cnt; }
    if (set == 0) {
        const size_t o = ((size_t)layer * 2 + 0) * DM * FF;
        CONV_MAT(p.in[7] + o, FF, DM, W + W_13_0, 1, 0)
        CONV_MAT(p.in[8] + o, FF, DM, W + W_13_0, 2, 0)
    } else {
        const size_t o0 = ((size_t)layer * 2 + 0) * DM * FF, o1 = ((size_t)layer * 2 + 1) * DM * FF;
        CONV_MAT(p.in[9] + o0, DM, FF, W + W_2_0, 0, 0)
        if (layer == 0) {
            CONV_MAT(p.in[10], 3 * DM, DM, W + W_HYIN, 0, 0)
            CONV_MAT(p.in[23], DM, DM, W + W_HYOUT, 0, 0)
        } else {
            CONV_MAT(p.in[25], 2 * DM, DM, W + W_RGIN, 0, 0)
            for (int d = 0; d < 2; ++d) for (int h = 0; h < 4; ++h) {
                CONV_MAT(p.in[29] + ((size_t)d * 4 + h) * 65536, 256, 256, W + W_GATE, 3, d | (0 << 1) | (h << 2))
                CONV_MAT(p.in[31] + ((size_t)d * 4 + h) * 65536, 256, 256, W + W_GATE, 3, d | (1 << 1) | (h << 2))
            }
            CONV_MAT(p.in[34], DM, DM, W + W_RGOUT, 0, 0)
        }
        CONV_MAT(p.in[7] + o1, FF, DM, W + W_13_1, 1, 0)
        CONV_MAT(p.in[8] + o1, FF, DM, W + W_13_1, 2, 0)
        CONV_MAT(p.in[9] + o1, DM, FF, W + W_2_1, 0, 0)
    }
#undef CONV_MAT
    return base;
}
__device__ __forceinline__ void convert_weights(PARG p, LAS unsigned char* lds, int layer, int set, int first_blk) {
    const int total = conv_items(p, lds, layer, set, -1);
    const int nb = (int)gridDim.x - first_blk;
    if ((int)blockIdx.x < first_blk) return;
    for (int t = (int)blockIdx.x - first_blk; t < total; t += nb) conv_items(p, lds, layer, set, t);
}

__device__ __forceinline__ void ada_phase(PARG p, LAS unsigned char* lds) {
    LAS float* sc = (LAS float*)lds;
    LAS float* red = sc + 9 * 1024;
    const int tid = threadIdx.x;
    bool loaded = false;
    float* MOD = (float*)(p.ws + OFF_MOD);
    for (int item = blockIdx.x; item < 288; item += gridDim.x) {
        if (!loaded) {
            for (int i = tid; i < 9 * 1024; i += 512) { const float v = (i < 8192) ? p.in[1][i] : p.in[3][i - 8192]; sc[i] = siluf_(v); }
            __syncthreads(); loaded = true;
        }
        const int l = item / 144, n0 = (item % 144) * 64, kc = tid >> 6, col = tid & 63;
        const float* w = p.in[4] + (size_t)l * DM * 9216 + n0 + col;
        float a[9];
#pragma unroll
        for (int m = 0; m < 9; ++m) a[m] = 0.f;
#pragma unroll 1
        for (int k0 = kc * 128; k0 < kc * 128 + 128; k0 += 32) {
            float wv[32];
#pragma unroll
            for (int i = 0; i < 32; ++i) wv[i] = w[(size_t)(k0 + i) * 9216];
#pragma unroll
            for (int i = 0; i < 32; ++i)
#pragma unroll
                for (int m = 0; m < 9; ++m) a[m] += sc[m * 1024 + k0 + i] * wv[i];
        }
#pragma unroll
        for (int m = 0; m < 9; ++m) red[(kc * 9 + m) * 64 + col] = a[m];
        __syncthreads();
        for (int i = tid; i < 9 * 64; i += 512) {
            const int m = i >> 6, c2 = i & 63; float s = 0.f;
#pragma unroll
            for (int q = 0; q < 8; ++q) s += red[(q * 9 + m) * 64 + c2];
            MOD[((size_t)l * 9 + m) * 9216 + n0 + c2] = s + p.in[5][(size_t)l * 9216 + n0 + c2];
        }
        __syncthreads();
    }
    __syncthreads();
}

__device__ __forceinline__ void filter_item(PARG p, LAS unsigned char* lds, int L, int k0, bf16_t* FT, int ldq) {
    LAS float* zf = (LAS float*)lds;
    LAS float* hA = zf + 16 * 64;
    LAS float* hB = hA + 16 * 64;
    LAS float* W0 = hB + 16 * 64;
    LAS float* W1 = W0 + 33 * 64;
    LAS float* W2 = W1 + 64 * 64;
    const int tid = threadIdx.x, w = tid >> 6, lane = tid & 63;
    const float* fb0 = p.in[15]; const float* fb1 = p.in[17]; const float* fb2 = p.in[19]; const float* freq = p.in[20]; const float* fwout = p.in[21];
    for (int i = tid; i < 33 * 64; i += 512) W0[i] = p.in[14][i];
    for (int i = tid; i < 64 * 64; i += 512) { W1[i] = p.in[16][i]; W2[i] = p.in[18][i]; }
#pragma unroll 1
    for (int pp = 0; pp < 2; ++pp) {
        const int pi = w * 2 + pp, k = k0 + pi;
        float f = 0.f;
        if (lane == 0) f = (float)k / (float)(L - 1);
        else if (lane < 33) {
            const int band = (lane - 1) & 15;
            const float fr = 1e-4f + (float)band * ((15.0f - 1e-4f) / 15.0f);
            const float wk = 6.283185307179586f * (float)k / (float)L;
            const float ph = fr * wk;
            f = (lane <= 16) ? cosf(ph) : -sinf(ph);
        }
        zf[pi * 64 + lane] = f;
    }
    __syncthreads();
    {
        const float b0 = fb0[lane], f0 = freq[lane];
        float a0 = b0, a1 = b0;
#pragma unroll 11
        for (int e = 0; e < 33; ++e) { const float wv = W0[e * 64 + lane]; a0 += zf[(w * 2) * 64 + e] * wv; a1 += zf[(w * 2 + 1) * 64 + e] * wv; }
        hA[(w * 2) * 64 + lane] = sinf(f0 * a0); hA[(w * 2 + 1) * 64 + lane] = sinf(f0 * a1);
    }
    __syncthreads();
    {
        const float b0 = fb1[lane], f0 = freq[64 + lane];
        float a0 = b0, a1 = b0;
#pragma unroll 16
        for (int e = 0; e < 64; ++e) { const float wv = W1[e * 64 + lane]; a0 += hA[(w * 2) * 64 + e] * wv; a1 += hA[(w * 2 + 1) * 64 + e] * wv; }
        hB[(w * 2) * 64 + lane] = sinf(f0 * a0); hB[(w * 2 + 1) * 64 + lane] = sinf(f0 * a1);
    }
    __syncthreads();
    {
        const float b0 = fb2[lane], f0 = freq[128 + lane];
        float a0 = b0, a1 = b0;
#pragma unroll 16
        for (int e = 0; e < 64; ++e) { const float wv = W2[e * 64 + lane]; a0 += hB[(w * 2) * 64 + e] * wv; a1 += hB[(w * 2 + 1) * 64 + e] * wv; }
        __syncthreads();
        hA[(w * 2) * 64 + lane] = sinf(f0 * a0); hA[(w * 2 + 1) * 64 + lane] = sinf(f0 * a1);
    }
    __syncthreads();
    const float min_decay = -3.0701134573253945f, max_decay = -15.350567286626973f;
#pragma unroll 1
    for (int q = 0; q < 4; ++q) {
        const int n = tid + 512 * q;
        float acc[16];
#pragma unroll
        for (int i = 0; i < 16; ++i) acc[i] = 0.f;
#pragma unroll 1
        for (int e0 = 0; e0 < 64; e0 += 32) {
            float wv[32];
#pragma unroll
            for (int e = 0; e < 32; ++e) wv[e] = fwout[(e0 + e) * 2048 + n];
#pragma unroll
            for (int e = 0; e < 32; ++e)
#pragma unroll
                for (int i = 0; i < 16; ++i) acc[i] += hA[i * 64 + e0 + e] * wv[e];
        }
        const int c = n & 1023; const bool bwd = n >= 1024;
        const float delta = fabsf(min_decay + (float)c * ((max_decay - min_decay) / 1023.0f));
        bf16_t* dst = FT + (size_t)c * ldq;
#pragma unroll
        for (int i = 0; i < 16; ++i) {
            const int k = k0 + i;
            const float tk = (float)k / (float)(L - 1);
            const float val = acc[i] * __expf(-tk * delta);
            if (!bwd) dst[(L - 1) - k] = (bf16_t)f2bf(val);
            else if (k >= 1) dst[(L - 1) + k] = (bf16_t)f2bf(val);
        }
        if (k0 == 0 && !bwd) dst[2 * L - 1] = 0;
    }
    __syncthreads();
}
__device__ __forceinline__ void filter_phase(PARG p, LAS unsigned char* lds) {
    for (int item = (int)gridDim.x - 1 - (int)blockIdx.x; item < 144; item += gridDim.x) {
        if (item < 128) filter_item(p, lds, SEQ, item * 16, (bf16_t*)(p.ws + OFF_FILT), 4096);
        else filter_item(p, lds, CTXL, (item - 128) * 16, (bf16_t*)(p.ws + OFF_FILTC), 512);
    }
}

struct EwArgs { int init; int has_h; int nrows; float coef; int lres, gate_i, gpost_i; int lh, gpre_i, shift_i, scale_i; int nks; };
__device__ __forceinline__ void ew_phase(PARG p, const EwArgs a) {
    const int lane = threadIdx.x & 63, wv = threadIdx.x >> 6;
    const float* MOD = (const float*)(p.ws + OFF_MOD);
    const float* NG = p.in[6];
    const bf16_t* Y = (const bf16_t*)(p.ws + OFF_Y);
    bf16_t* H = (bf16_t*)(p.out);
    for (int row = blockIdx.x * 8 + wv; row < a.nrows; row += gridDim.x * 8) {
        const int midx = row < T_LAT ? (row >> 11) : 8;
        bf16_t* xp = (bf16_t*)(p.ws + OFF_H) + (size_t)row * DM;
        f32x4 x[4], g[4], sh[4], scl[4];
        if (a.has_h) {
#pragma unroll
            for (int q = 0; q < 4; ++q) {
                const int col = q * 256 + lane * 4;
                g[q] = *(const f32x4*)(NG + ((size_t)a.lh * 6 + a.gpre_i) * DM + col);
                sh[q] = *(const f32x4*)(MOD + ((size_t)a.lh * 9 + midx) * 9216 + a.shift_i * DM + col);
                scl[q] = *(const f32x4*)(MOD + ((size_t)a.lh * 9 + midx) * 9216 + a.scale_i * DM + col);
            }
        }
        if (a.init) {
            if (row < T_LAT) {
                const int t = row & (SEQ - 1); const float pr = (float)(t >> 6), pc = (float)(t & 63);
#pragma unroll
                for (int q = 0; q < 4; ++q) {
                    const int col = q * 256 + lane * 4;
                    f32x4 v = *(const f32x4*)(p.in[0] + (size_t)row * DM + col);
#pragma unroll
                    for (int j = 0; j < 4; ++j) {
                        const int d = col + j, i = d & 255;
                        const float om = __expf(-(float)i * (9.210340371976184f / 256.0f));
                        const float ang = ((d < 512) ? pr : pc) * om;
                        v[j] += ((d >> 8) & 1) ? __cosf(ang) : __sinf(ang);
                    }
                    x[q] = v;
                }
            } else {
#pragma unroll
                for (int q = 0; q < 4; ++q) x[q] = *(const f32x4*)(p.in[2] + (size_t)(row - T_LAT) * DM + q * 256 + lane * 4);
            }
        } else {
            f32x4 y[4], gt[4], gp[4]; u32x2 yr[4]; float ss = 0.f;
#pragma unroll
            for (int q = 0; q < 4; ++q) {
                const int col = q * 256 + lane * 4;
                { const u32x2 xv = *(const u32x2*)(xp + col); x[q] = (f32x4){bf2f(xv.x & 0xffffu), bf2f(xv.x >> 16), bf2f(xv.y & 0xffffu), bf2f(xv.y >> 16)}; }
                yr[q] = *(const u32x2*)(Y + (size_t)row * DM + col);
                gt[q] = *(const f32x4*)(MOD + ((size_t)a.lres * 9 + midx) * 9216 + a.gate_i * DM + col);
                gp[q] = *(const f32x4*)(NG + ((size_t)a.lres * 6 + a.gpost_i) * DM + col);
            }
#pragma unroll
            for (int q = 0; q < 4; ++q) {
                y[q] = (f32x4){bf2f(yr[q].x & 0xffffu), bf2f(yr[q].x >> 16), bf2f(yr[q].y & 0xffffu), bf2f(yr[q].y >> 16)};
                if (row >= T_LAT) for (int k = 0; k + 1 < a.nks; ++k) {
                    const u32x2 pr2 = *(const u32x2*)((const bf16_t*)(p.ws + OFF_YP) + ((size_t)k * 2048 + (row - T_LAT)) * DM + q * 256 + lane * 4);
                    y[q] = y[q] + (f32x4){bf2f(pr2.x & 0xffffu), bf2f(pr2.x >> 16), bf2f(pr2.y & 0xffffu), bf2f(pr2.y >> 16)};
                }
#pragma unroll
                for (int j = 0; j < 4; ++j) ss += y[q][j] * y[q][j];
            }
            ss = wave_sum(ss);
            const float r = a.coef * rsqrtf(ss * (1.0f / DM) + 1e-6f);
#pragma unroll
            for (int q = 0; q < 4; ++q) x[q] = x[q] + (r * gt[q]) * (y[q] * gp[q]);
        }
        if (!a.has_h) {
#pragma unroll
            for (int q = 0; q < 4; ++q) *(f32x4*)(p.out + (size_t)row * DM + q * 256 + lane * 4) = x[q];
        } else {
#pragma unroll
            for (int q = 0; q < 4; ++q) { u32x2 w; w.x = pack2(x[q][0], x[q][1]); w.y = pack2(x[q][2], x[q][3]); *(u32x2*)(xp + q * 256 + lane * 4) = w; }
        }
        if (a.has_h) {
            float ss = 0.f;
#pragma unroll
            for (int q = 0; q < 4; ++q)
#pragma unroll
                for (int j = 0; j < 4; ++j) ss += x[q][j] * x[q][j];
            ss = wave_sum(ss);
            const float r = rsqrtf(ss * (1.0f / DM) + 1e-6f);
#pragma unroll
            for (int q = 0; q < 4; ++q) {
                const int col = q * 256 + lane * 4;
                const f32x4 h = (x[q] * r) * g[q] * (scl[q] + 1.0f) + sh[q];
                u32x2 w; w.x = pack2(h[0], h[1]); w.y = pack2(h[2], h[3]);
                *(u32x2*)(H + (size_t)row * DM + col) = w;
            }
        }
    }
}

template <int L>
__device__ __forceinline__ void longconv_channel(PARG p, LAS unsigned char* lds, int c) {
    constexpr int NBLK = L / 64, NCOL = NBLK * 8, FLEN = 2 * L, CSTRIDE = FLEN * 2 + 32, ZSTRIDE = 144;
    constexpr int Z_OFF = 8 * CSTRIDE;
    constexpr int MB = (L == SEQ) ? 4 : 1, CBW = (L == SEQ) ? 2 : 1;
    static_assert(Z_OFF + NCOL * ZSTRIDE <= LDS_MAIN, "lds");
    const int tid = threadIdx.x, wid = tid >> 6, lane = tid & 63, fr = lane & 15, fq = lane >> 4;
    const int tok0 = (L == SEQ) ? 0 : T_LAT;
    const bf16_t* UT = (const bf16_t*)(p.ws + OFF_BIG);
    const bf16_t* FT = (L == SEQ) ? (const bf16_t*)(p.ws + OFF_FILT) + (size_t)c * 4096 : (const bf16_t*)(p.ws + OFF_FILTC) + (size_t)c * 512;
    bf16_t* YT = (bf16_t*)(p.ws + OFF_Y);
    const float* cw = p.in[12]; const float* cb = p.in[13];
    for (int v = tid; v < FLEN / 8; v += 512) *(LAS u32x4*)(lds + v * 16) = *(const u32x4*)(FT + v * 8);
    {
        const float w10 = cw[0 * 3072 + 1024 + c], w11 = cw[1 * 3072 + 1024 + c], w12 = cw[2 * 3072 + 1024 + c], b1 = cb[1024 + c];
        const float w20 = cw[0 * 3072 + 2048 + c], w21 = cw[1 * 3072 + 2048 + c], w22 = cw[2 * 3072 + 2048 + c], b2 = cb[2048 + c];
        const bf16_t* r1 = UT + (size_t)(1024 + c) * T_ALL + tok0; const bf16_t* r2 = UT + (size_t)(2048 + c) * T_ALL + tok0;
        for (int g = tid; g < NB * L / 8; g += 512) {
            const int b = g / (L / 8), t0 = (g % (L / 8)) * 8;
            const size_t o = (size_t)b * L + t0;
            const u32x4 a = *(const u32x4*)(r1 + o); const u32x4 bq = *(const u32x4*)(r2 + o);
            float x1[10], x2[10];
            x1[0] = t0 > 0 ? bf2f(r1[o - 1]) : 0.f; x2[0] = t0 > 0 ? bf2f(r2[o - 1]) : 0.f;
            x1[9] = t0 + 8 < L ? bf2f(r1[o + 8]) : 0.f; x2[9] = t0 + 8 < L ? bf2f(r2[o + 8]) : 0.f;
#pragma unroll
            for (int j = 0; j < 4; ++j) { x1[1 + 2 * j] = bf2f(a[j] & 0xffffu); x1[2 + 2 * j] = bf2f(a[j] >> 16); x2[1 + 2 * j] = bf2f(bq[j] & 0xffffu); x2[2 + 2 * j] = bf2f(bq[j] >> 16); }
            float z[8];
#pragma unroll
            for (int j = 0; j < 8; ++j) z[j] = (b1 + w10 * x1[j] + w11 * x1[j + 1] + w12 * x1[j + 2]) * (b2 + w20 * x2[j] + w21 * x2[j + 1] + w22 * x2[j + 2]);
            u32x4 w; w.x = pack2(z[0], z[1]); w.y = pack2(z[2], z[3]); w.z = pack2(z[4], z[5]); w.w = pack2(z[6], z[7]);
            *(LAS u32x4*)(lds + Z_OFF + ((t0 >> 6) * 8 + b) * ZSTRIDE + (t0 & 63) * 2) = w;
        }
    }
    __syncthreads();
    {
        const LAS unsigned* D = (const LAS unsigned*)lds;
        for (int v = tid; v < FLEN / 8; v += 512) {
            unsigned d[8];
#pragma unroll
            for (int i = 0; i < 8; ++i) d[i] = D[4 * v + i];
#pragma unroll
            for (int j = 1; j < 8; ++j) {
                u32x4 w;
#pragma unroll
                for (int i = 0; i < 4; ++i) w[i] = (j & 1) ? __builtin_amdgcn_alignbyte(d[i + (j + 1) / 2], d[i + (j - 1) / 2], 2) : d[i + j / 2];
                *(LAS u32x4*)(lds + j * CSTRIDE + v * 16) = w;
            }
        }
    }
    __syncthreads();
    const int mb0 = (L == SEQ) ? 0 : (wid & 3), cb0 = (L == SEQ) ? 2 * wid : (wid >> 2);
    f32x4 acc[CBW][MB];
#pragma unroll
    for (int x = 0; x < CBW; ++x)
#pragma unroll
        for (int m = 0; m < MB; ++m) acc[x][m] = (f32x4){0.f, 0.f, 0.f, 0.f};
    const int jj = (7 - fr) & 7;
    const int abase = jj * CSTRIDE + 2 * ((L - 1) - fr - jj + 8 * fq);
    const int ilo = 2 * cb0, ihi = 2 * (cb0 + CBW) - 1;
    if constexpr (L == SEQ) {
        const int col = 16 * cb0 + fr, ib = col >> 3;
        auto getB = [&](int dd, bf16x8 (&o)[2]) {
            const int ip = ib - dd; const bool ok = (ip >= 0) && (ip < NBLK); const int colp = ok ? col - 8 * dd : col;
#pragma unroll
            for (int k = 0; k < 2; ++k) { bf16x8 v = *(const LAS bf16x8*)(lds + Z_OFF + colp * ZSTRIDE + (32 * k + 8 * fq) * 2); if (!ok) v = (bf16x8){0, 0, 0, 0, 0, 0, 0, 0}; o[k] = v; }
        };
        const int d0 = ilo - (NBLK - 1);
        bf16x8 F[6], h0[2], h1[2], bn[2];
        getB(d0 - 2, h0); getB(d0 - 1, h1);
        F[4] = *(const LAS bf16x8*)(lds + abase - 32 * (4 * d0 - 2)); F[5] = *(const LAS bf16x8*)(lds + abase - 32 * (4 * d0 - 1));
#pragma unroll 2
        for (int d = d0; d <= ihi; ++d) {
            F[0] = F[4]; F[1] = F[5];
#pragma unroll
            for (int i = 2; i < 6; ++i) F[i] = *(const LAS bf16x8*)(lds + abase - 32 * (4 * d - 2 + i));
            getB(d, bn);
#pragma unroll
            for (int m = 0; m < 4; ++m) {
                acc[0][m] = __builtin_amdgcn_mfma_f32_16x16x32_bf16(F[m + 2], bn[0], acc[0][m], 0, 0, 0);
                acc[0][m] = __builtin_amdgcn_mfma_f32_16x16x32_bf16(F[m], bn[1], acc[0][m], 0, 0, 0);
                acc[1][m] = __builtin_amdgcn_mfma_f32_16x16x32_bf16(F[m + 2], h0[0], acc[1][m], 0, 0, 0);
                acc[1][m] = __builtin_amdgcn_mfma_f32_16x16x32_bf16(F[m], h0[1], acc[1][m], 0, 0, 0);
            }
            h0[0] = h1[0]; h0[1] = h1[1]; h1[0] = bn[0]; h1[1] = bn[1];
        }
    } else {
    for (int d = ilo - (NBLK - 1); d <= ihi; ++d) {
        bf16x8 af[MB][2];
#pragma unroll
        for (int m = 0; m < MB; ++m)
#pragma unroll
            for (int k = 0; k < 2; ++k) af[m][k] = *(const LAS bf16x8*)(lds + abase + 2 * (-64 * d - 16 * (mb0 + m) + 32 * k));
#pragma unroll
        for (int x = 0; x < CBW; ++x) {
            const int col = 16 * (cb0 + x) + fr, ip = (col >> 3) - d;
            const bool ok = (ip >= 0) && (ip < NBLK);
            const int colp = ok ? col - 8 * d : col;
            bf16x8 bfr[2];
#pragma unroll
            for (int k = 0; k < 2; ++k) {
                bf16x8 v = *(const LAS bf16x8*)(lds + Z_OFF + colp * ZSTRIDE + (32 * k + 8 * fq) * 2);
                if (!ok) v = (bf16x8){0, 0, 0, 0, 0, 0, 0, 0};
                bfr[k] = v;
            }
#pragma unroll
            for (int m = 0; m < MB; ++m)
#pragma unroll
                for (int k = 0; k < 2; ++k) acc[x][m] = __builtin_amdgcn_mfma_f32_16x16x32_bf16(af[m][k], bfr[k], acc[x][m], 0, 0, 0);
        }
    }
    }
    {
        const float w00 = cw[0 * 3072 + c], w01 = cw[1 * 3072 + c], w02 = cw[2 * 3072 + c], b0 = cb[c], fbias = p.in[22][c];
        const bf16_t* r0 = UT + (size_t)c * T_ALL + tok0;
#pragma unroll
        for (int x = 0; x < CBW; ++x)
#pragma unroll
            for (int m = 0; m < MB; ++m) {
                const int col = 16 * (cb0 + x) + fr, i = col >> 3, b = col & 7, r = 16 * (mb0 + m) + 4 * fq, t = 64 * i + r;
                const size_t o = (size_t)b * L + t;
                const u32x2 xr = *(const u32x2*)(r0 + o);
                float xv[6];
                xv[0] = t > 0 ? bf2f(r0[o - 1]) : 0.f; xv[5] = t + 4 < L ? bf2f(r0[o + 4]) : 0.f;
                xv[1] = bf2f(xr.x & 0xffffu); xv[2] = bf2f(xr.x >> 16); xv[3] = bf2f(xr.y & 0xffffu); xv[4] = bf2f(xr.y >> 16);
                const u32x2 zr = *(const LAS u32x2*)(lds + Z_OFF + col * ZSTRIDE + r * 2);
                const float zv[4] = {bf2f(zr.x & 0xffffu), bf2f(zr.x >> 16), bf2f(zr.y & 0xffffu), bf2f(zr.y >> 16)};
                float o4[4];
#pragma unroll
                for (int j = 0; j < 4; ++j) o4[j] = (b0 + w00 * xv[j] + w01 * xv[j + 1] + w02 * xv[j + 2]) * (acc[x][m][j] + fbias * zv[j]);
                u32x2 w; w.x = pack2(o4[0], o4[1]); w.y = pack2(o4[2], o4[3]);
                *(u32x2*)(YT + (size_t)c * T_ALL + tok0 + o) = w;
            }
    }
    __syncthreads();
}
__device__ __forceinline__ void longconv_phase(PARG p, LAS unsigned char* lds) {
    for (int c = blockIdx.x; c < DM; c += gridDim.x) longconv_channel<SEQ>(p, lds, c);
    for (int c = blockIdx.x; c < DM; c += gridDim.x) longconv_channel<CTXL>(p, lds, c);
}

__device__ __forceinline__ void transpose_phase(PARG p, LAS unsigned char* lds) {
    const bf16_t* S = (const bf16_t*)(p.ws + OFF_Y); bf16_t* Dst = (bf16_t*)(p.out);
    LAS bf16_t* t = (LAS bf16_t*)lds;
    const int tid = threadIdx.x;
    for (int item = blockIdx.x; item < 16 * (T_ALL / 64); item += gridDim.x) {
        const int c0 = (item & 15) * 64, t0 = (item >> 4) * 64;
        { const int c = tid >> 3, t8 = (tid & 7) * 8;
          *(LAS u32x4*)(t + c * 72 + t8) = *(const u32x4*)(S + (size_t)(c0 + c) * T_ALL + t0 + t8); }
        __syncthreads();
        { const int tt = tid >> 3, c8 = (tid & 7) * 8;
          unsigned v[8];
#pragma unroll
          for (int j = 0; j < 8; ++j) v[j] = t[(c8 + j) * 72 + tt];
          u32x4 w; w.x = v[0] | (v[1] << 16); w.y = v[2] | (v[3] << 16); w.z = v[4] | (v[5] << 16); w.w = v[6] | (v[7] << 16);
          *(u32x4*)(Dst + (size_t)(t0 + tt) * DM + c0 + c8) = w; }
        __syncthreads();
    }
}

__device__ __forceinline__ void rgconv_phase(PARG p) {
    const bf16_t* R = (const bf16_t*)(p.ws + OFF_BIG + 37748736); bf16_t* XC = (bf16_t*)(p.out);
    const float* cw = p.in[27]; const float* cb = p.in[28];
    for (int it = blockIdx.x * 512 + threadIdx.x; it < T_ALL * 128; it += gridDim.x * 512) {
        const int row = it >> 7, c8 = (it & 127) * 8;
        int t, L;
        if (row < T_LAT) { t = row & (SEQ - 1); L = SEQ; } else { t = (row - T_LAT) & (CTXL - 1); L = CTXL; }
        float o[8];
#pragma unroll
        for (int j = 0; j < 8; ++j) o[j] = cb[c8 + j];
#pragma unroll
        for (int k = 0; k < 4; ++k) {
            const int tt = t + k - 1;
            if (tt >= 0 && tt < L) {
                const u32x4 v = *(const u32x4*)(R + (size_t)(row + k - 1) * DM + c8);
                const f32x4 w0 = *(const f32x4*)(cw + k * DM + c8), w1 = *(const f32x4*)(cw + k * DM + c8 + 4);
#pragma unroll
                for (int j = 0; j < 4; ++j) { const float lo = bf2f(v[j] & 0xffffu), hi = bf2f(v[j] >> 16);
                    o[2 * j] += lo * (j < 2 ? w0[2 * j] : w1[2 * j - 4]); o[2 * j + 1] += hi * (j < 2 ? w0[2 * j + 1] : w1[2 * j - 3]); }
            }
        }
        u32x4 w; w.x = pack2(o[0], o[1]); w.y = pack2(o[2], o[3]); w.z = pack2(o[4], o[5]); w.w = pack2(o[6], o[7]);
        *(u32x4*)(XC + (size_t)row * DM + c8) = w;
    }
}

__device__ __forceinline__ int scan_row(int dir, int b, int q) {
    if (q < CTXL) return T_LAT + b * CTXL + (dir ? (CTXL - 1 - q) : q);
    const int t = q - CTXL; return b * SEQ + (dir ? (SEQ - 1 - t) : t);
}
__device__ __forceinline__ void scan_agg_phase(PARG p) {
    const unsigned* GA0 = (const unsigned*)(p.ws + OFF_BIG + 37748736); const unsigned* GA1 = (const unsigned*)(p.ws + OFF_EXTRA);
    f32x2* AGG = (f32x2*)(p.ws + OFF_Y);
    const int lane = threadIdx.x & 63, wv = threadIdx.x >> 6;
    for (int item = blockIdx.x * 8 + wv; item < 2 * 8 * 36 * 16; item += gridDim.x * 8) {
        const int cg_ = item & 15, k = (item >> 4) % 36, b = ((item >> 4) / 36) & 7, dir = (item >> 4) / 288;
        const int ch = cg_ * 64 + lane;
        const unsigned* GA = dir ? GA1 : GA0;
        const int r0 = scan_row(dir, b, 64 * k); const int step = dir ? -1 : 1;
        float A = 1.f, Bv = 0.f;
#pragma unroll 16
        for (int s = 0; s < 64; ++s) {
            const unsigned v = GA[(size_t)(r0 + step * s) * DM + ch];
            const float a = __expf(bf2f(v & 0xffffu)), bb = bf2f(v >> 16);
            A *= a; Bv = a * Bv + bb;
        }
        AGG[(((size_t)dir * 8 + b) * 36 + k) * DM + ch] = (f32x2){A, Bv};
    }
}
__device__ __forceinline__ void scan_out_phase(PARG p) {
    const unsigned* GA0 = (const unsigned*)(p.ws + OFF_BIG + 37748736); const unsigned* GA1 = (const unsigned*)(p.ws + OFF_EXTRA);
    const f32x2* AGG = (const f32x2*)(p.ws + OFF_Y);
    const bf16_t* G = (const bf16_t*)(p.ws + OFF_BIG);
    bf16_t* H = (bf16_t*)(p.out);
    const int lane = threadIdx.x & 63, wv = threadIdx.x >> 6;
    for (int item = blockIdx.x * 8 + wv; item < 8 * 32 * 16; item += gridDim.x * 8) {
        const int cg_ = item & 15, kl = (item >> 4) & 31, b = item >> 9;
        const int ch = cg_ * 64 + lane;
        float hf = 0.f, hr = 0.f;
        {
            const f32x2* ag0 = AGG + ((size_t)0 * 8 + b) * 36 * DM + ch; const int n0 = 4 + kl;
            const f32x2* ag1 = AGG + ((size_t)1 * 8 + b) * 36 * DM + ch; const int n1 = 4 + (31 - kl);
#pragma unroll 1
            for (int k0 = 0; k0 < 36; k0 += 12) {
                f32x2 v0[12], v1[12];
#pragma unroll
                for (int k = 0; k < 12; ++k) { v0[k] = (k0 + k < n0) ? ag0[(size_t)(k0 + k) * DM] : (f32x2){1.f, 0.f}; v1[k] = (k0 + k < n1) ? ag1[(size_t)(k0 + k) * DM] : (f32x2){1.f, 0.f}; }
#pragma unroll
                for (int k = 0; k < 12; ++k) { hf = v0[k].x * hf + v0[k].y; hr = v1[k].x * hr + v1[k].y; }
            }
            asm volatile("" ::: "memory");
        }
        const int row0 = b * SEQ + kl * 64;
        float hs[64];
#pragma unroll
        for (int s = 0; s < 64; ++s) {
            const unsigned v = GA0[(size_t)(row0 + s) * DM + ch];
            hf = __expf(bf2f(v & 0xffffu)) * hf + bf2f(v >> 16); hs[s] = hf;
        }
#pragma unroll
        for (int s = 63; s >= 0; --s) {
            const unsigned v = GA1[(size_t)(row0 + s) * DM + ch];
            hr = __expf(bf2f(v & 0xffffu)) * hr + bf2f(v >> 16);
            const float g = bf2f(G[(size_t)(row0 + s) * DM + ch]);
            H[(size_t)(row0 + s) * DM + ch] = (bf16_t)(cvt_pk_bf16((hs[s] + hr) * geluf_(g), 0.f) & 0xffffu);
        }
    }
}


#define XB_TMO      128
#define XB_XCNT(j)  (256  + 64 * (j))
#define XB_XSUB(j)  (1280 + 64 * (j))
#define XB_XGEN(j)  (2304 + 64 * (j))
#define XB_TOP      3328
#define XB_TOPGEN   3392
#define XCD_BAR_WORDS 3456
#define XB_SPIN_CAP (1u << 18)
__device__ __forceinline__ unsigned xb_ld(unsigned* p)              { return __hip_atomic_load(p, __ATOMIC_RELAXED, __HIP_MEMORY_SCOPE_AGENT); }
__device__ __forceinline__ unsigned xb_add(unsigned* p, unsigned v) { return __hip_atomic_fetch_add(p, v, __ATOMIC_RELAXED, __HIP_MEMORY_SCOPE_AGENT); }
__device__ __forceinline__ unsigned xb_xcc_id() { return (unsigned)__builtin_amdgcn_s_getreg((3 << 11) | 20) & 0xFu; }
#define XB_SPIN(cond, bar) do { unsigned _sp = 0; while (cond) { __builtin_amdgcn_s_sleep(1); \
    if ((++_sp & 255u) == 0u) { if (xb_ld(&(bar)[XB_TMO])) break; if (_sp > XB_SPIN_CAP) { atomicAdd(&(bar)[XB_TMO], 1u); break; } } } } while (0)
struct XcdBarrier { unsigned* bar; unsigned x; volatile LAS unsigned* st; };
__device__ __forceinline__ XcdBarrier xcd_barrier_post(unsigned* bar, volatile LAS unsigned* st) {
    XcdBarrier b; b.bar = bar; b.x = xb_xcc_id(); b.st = st;
    if (threadIdx.x == 0) (void)xb_add(&bar[XB_XCNT(b.x)], 1u);
    return b;
}
__device__ __forceinline__ void xcd_barrier_complete(unsigned* bar, unsigned x, unsigned& nloc, unsigned& nx) {
    const unsigned G = gridDim.x * gridDim.y * gridDim.z;
    unsigned sum, cnt, mine, sp = 0u;
    for (;;) {
        sum = 0u; cnt = 0u; mine = 0u;
#pragma unroll
        for (unsigned j = 0; j < 16; ++j) { const unsigned c = xb_ld(&bar[XB_XCNT(j)]); sum += c; cnt += (c > 0u) ? 1u : 0u; mine = (j == x) ? c : mine; }
        if (sum == G) break;
        __builtin_amdgcn_s_sleep(1);
        if ((++sp & 255u) == 0u) { if (xb_ld(&bar[XB_TMO])) break; if (sp > XB_SPIN_CAP) { atomicAdd(&bar[XB_TMO], 1u); break; } }
    }
    nloc = mine > 0u ? mine : 1u; nx = cnt > 0u ? cnt : 1u;
}
__device__ __forceinline__ void xcd_barrier(const XcdBarrier& b) {
    asm volatile("s_waitcnt vmcnt(0)" ::: "memory");
    __syncthreads();
    if (threadIdx.x == 0) {
        unsigned* bar = b.bar;
        __builtin_amdgcn_s_waitcnt(0);
        unsigned nloc = b.st[0], nx = b.st[1];
        if (nloc == 0u) { xcd_barrier_complete(bar, b.x, nloc, nx); b.st[0] = nloc; b.st[1] = nx; }
        const unsigned old = xb_add(&bar[XB_XSUB(b.x)], 1u);
        const unsigned gen = old / nloc;
        if (old + 1u == (gen + 1u) * nloc) {
            __builtin_amdgcn_fence(__ATOMIC_RELEASE, "agent");
            asm volatile("s_waitcnt vmcnt(0)" ::: "memory");
            const unsigned og = xb_add(&bar[XB_TOP], 1u);
            const unsigned tg = og / nx;
            if (og + 1u == (tg + 1u) * nx) xb_add(&bar[XB_TOPGEN], 1u);
            else XB_SPIN(xb_ld(&bar[XB_TOPGEN]) == tg, bar);
            __builtin_amdgcn_fence(__ATOMIC_ACQUIRE, "agent");
            xb_add(&bar[XB_XGEN(b.x)], 1u);
            asm volatile("s_waitcnt vmcnt(0)" ::: "memory");
        } else {
            XB_SPIN(xb_ld(&bar[XB_XGEN(b.x)]) == gen, bar);
            __builtin_amdgcn_fence(__ATOMIC_ACQUIRE, "agent");
            asm volatile("s_waitcnt vmcnt(0)" ::: "memory");
        }
    }
    __syncthreads();
}

__device__ __forceinline__ void run_gemm1(PARG p, LAS unsigned char* lds, int s, int M) {
    const bf16_t* W = (const bf16_t*)(p.ws + OFF_W);
    pg8::Gemm g{(const bf16_t*)(p.out), W + (s ? W_13_1 : W_13_0), M, 2 * FF, DM, DM, DM, 1 << 20, 0};
    pg8::StaticOrder S; S.init(T_LAT, g.N, g.K, gridDim.x, blockIdx.x, (M - T_LAT) / 256, 1);
    pg8::EpiSwiglu E{(bf16_t*)(p.ws + OFF_BIG)};
    pg8::gemm_phase(lds, g, S, E);
}
__device__ __forceinline__ void run_gemm2(PARG p, LAS unsigned char* lds, int s, int M) {
    const bf16_t* W = (const bf16_t*)(p.ws + OFF_W);
    pg8::Gemm g{(const bf16_t*)(p.ws + OFF_BIG), W + (s ? W_2_1 : W_2_0), M, DM, FF, FF, FF, 1 << 20, 0};
    pg8::StaticOrder S; S.init(T_LAT, g.N, g.K, gridDim.x, blockIdx.x, (M - T_LAT) / 256, 2);
    pg8::EpiBf16 E{(bf16_t*)(p.ws + OFF_Y), DM, nullptr, nullptr, 0, 0, (bf16_t*)(p.ws + OFF_YP)};
    pg8::gemm_phase(lds, g, S, E);
}

#ifndef PHSEL
#define PHSEL -1
#endif
__device__ __forceinline__ void run_phase(PARG p, LAS unsigned char* lds, int ph) {
    const bf16_t* W = (const bf16_t*)(p.ws + OFF_W);
    switch (ph) {
    case 0: if (PHSEL >= 0 && PHSEL != 0) break; ada_phase(p, lds); filter_phase(p, lds); convert_weights(p, lds, 0, 0, 0); break;
    case 1: if (PHSEL >= 0 && PHSEL != 1) break; ew_phase(p, EwArgs{1, 1, T_ALL, 0.f, 0, 0, 0, 0, 0, 0, 1, 1}); break;
    case 2: if (PHSEL >= 0 && PHSEL != 2) break; run_gemm1(p, lds, 0, T_ALL); convert_weights(p, lds, 0, 1, 48); break;
    case 3: if (PHSEL >= 0 && PHSEL != 3) break; run_gemm2(p, lds, 0, T_ALL); break;
    case 4: if (PHSEL >= 0 && PHSEL != 4) break; ew_phase(p, EwArgs{0, 1, T_ALL, 0.5f, 0, 2, 1, 0, 2, 3, 4, 2}); break;
    case 5: if (PHSEL >= 0 && PHSEL != 5) break; {
        pg8::Gemm g{W + W_HYIN, (const bf16_t*)(p.out), 3 * DM, T_ALL, DM, DM, DM, 1 << 20, 0};
        pg8::StaticOrder S; S.init(g.M, g.N, g.K, gridDim.x, blockIdx.x, 0, 1);
        pg8::EpiBf16 E{(bf16_t*)(p.ws + OFF_BIG), T_ALL, nullptr, p.in[11], 0, 0, nullptr};
        pg8::gemm_phase(lds, g, S, E);
    } break;
    case 6: if (PHSEL >= 0 && PHSEL != 6) break; longconv_phase(p, lds); break;
    case 7: if (PHSEL >= 0 && PHSEL != 7) break; transpose_phase(p, lds); break;
    case 8: if (PHSEL >= 0 && PHSEL != 8) break; {
        pg8::Gemm g{(const bf16_t*)(p.out), W + W_HYOUT, T_ALL, DM, DM, DM, DM, 1 << 20, 0};
        pg8::StaticOrder S; S.init(T_LAT, g.N, g.K, gridDim.x, blockIdx.x, 8, 4);
        pg8::EpiBf16 E{(bf16_t*)(p.ws + OFF_Y), DM, p.in[24], nullptr, 0, 0, (bf16_t*)(p.ws + OFF_YP)};
        pg8::gemm_phase(lds, g, S, E);
    } break;
    case 9: if (PHSEL >= 0 && PHSEL != 9) break; ew_phase(p, EwArgs{0, 1, T_ALL, 1.0f, 0, 5, 3, 0, 4, 6, 7, 4}); break;
    case 10: if (PHSEL >= 0 && PHSEL != 10) break; run_gemm1(p, lds, 1, T_ALL); break;
    case 11: if (PHSEL >= 0 && PHSEL != 11) break; run_gemm2(p, lds, 1, T_ALL); break;
    case 12: if (PHSEL >= 0 && PHSEL != 12) break; ew_phase(p, EwArgs{0, 1, T_ALL, 0.5f, 0, 8, 5, 1, 0, 0, 1, 2}); convert_weights(p, lds, 1, 0, 0);
        if (blockIdx.x == gridDim.x - 1) for (int i = threadIdx.x; i < 2 * DM; i += 512) ((float*)(p.ws + OFF_SP8))[i] = -8.0f * log1pf(__expf(-p.in[33][i]));
        break;
    case 13: if (PHSEL >= 0 && PHSEL != 13) break; run_gemm1(p, lds, 0, T_ALL); convert_weights(p, lds, 1, 1, 48); break;
    case 14: if (PHSEL >= 0 && PHSEL != 14) break; run_gemm2(p, lds, 0, T_ALL); break;
    case 15: if (PHSEL >= 0 && PHSEL != 15) break; ew_phase(p, EwArgs{0, 1, T_ALL, 0.5f, 1, 2, 1, 1, 2, 3, 4, 2}); break;
    case 16: if (PHSEL >= 0 && PHSEL != 16) break; {
        pg8::Gemm g{(const bf16_t*)(p.out), W + W_RGIN, T_ALL, 2 * DM, DM, DM, DM, 1 << 20, 0};
        pg8::StaticOrder S; S.init(T_LAT, g.N, g.K, gridDim.x, blockIdx.x, 8, 1);
        pg8::EpiBf16 E{(bf16_t*)(p.ws + OFF_BIG), DM, p.in[26], nullptr, DM, (size_t)T_ALL * DM, nullptr};
        pg8::gemm_phase(lds, g, S, E);
    } break;
    case 17: if (PHSEL >= 0 && PHSEL != 17) break; rgconv_phase(p); break;
    case 18: if (PHSEL >= 0 && PHSEL != 18) break; {
        pg8::Gemm g{(const bf16_t*)(p.out), W + W_GATE, T_ALL, 4096, 256, DM, 256, 4, 256};
        pg8::StaticOrder S; S.init(T_LAT, g.N, g.K, gridDim.x, blockIdx.x, 8, 1);
        pg8::EpiGate E{(unsigned*)(p.ws + OFF_BIG + 37748736), (unsigned*)(p.ws + OFF_EXTRA), (const bf16_t*)(p.out), p.in[30], p.in[32], (const float*)(p.ws + OFF_SP8), (f32x2*)(p.ws + OFF_Y)};
        pg8::gemm_phase(lds, g, S, E);
    } break;
    case 19: break;
    case 20: if (PHSEL >= 0 && PHSEL != 20) break; scan_out_phase(p); break;
    case 21: if (PHSEL >= 0 && PHSEL != 21) break; {
        pg8::Gemm g{(const bf16_t*)(p.out), W + W_RGOUT, T_LAT, DM, DM, DM, DM, 1 << 20, 0};
        pg8::StaticOrder S; S.init(T_LAT, g.N, g.K, gridDim.x, blockIdx.x, 0, 1);
        pg8::EpiBf16 E{(bf16_t*)(p.ws + OFF_Y), DM, p.in[35], nullptr, 0, 0, nullptr};
        pg8::gemm_phase(lds, g, S, E);
    } break;
    case 22: if (PHSEL >= 0 && PHSEL != 22) break; ew_phase(p, EwArgs{0, 1, T_LAT, 1.0f, 1, 5, 3, 1, 4, 6, 7, 1}); break;
    case 23: if (PHSEL >= 0 && PHSEL != 23) break; run_gemm1(p, lds, 1, T_LAT); break;
    case 24: if (PHSEL >= 0 && PHSEL != 24) break; run_gemm2(p, lds, 1, T_LAT); break;
    case 25: if (PHSEL >= 0 && PHSEL != 25) break; ew_phase(p, EwArgs{0, 0, T_LAT, 0.5f, 1, 8, 5, 0, 0, 0, 0, 1}); break;
    default: break;
    }
}

__global__ void __launch_bounds__(512, 2) mega_kernel(Params p) {
    extern __shared__ __attribute__((aligned(16))) unsigned char shm[];
    LAS unsigned char* lds = (LAS unsigned char*)shm;
    cg::grid_group grid = cg::this_grid();
    typedef const __attribute__((address_space(4))) Params* KP;
    const KP kp = (KP)__builtin_amdgcn_kernarg_segment_ptr();
    volatile LAS unsigned* st = (volatile LAS unsigned*)(lds + LDS_MAIN);
    if (threadIdx.x == 0) { st[0] = 0u; st[1] = 0u; }
    __syncthreads();
    XcdBarrier xb; xb.bar = nullptr; xb.x = 0; xb.st = st;
    if (kp->ph_hi - kp->ph_lo > 1) xb = xcd_barrier_post((unsigned*)(kp->ws + OFF_BAR), st);
    if (kp->ph_hi > 4096) grid.sync();
#define PH(k) { KP q = kp; asm volatile("" : "+s"(q)); const int lo_ = q->ph_lo, hi_ = q->ph_hi; if (lo_ <= (k) && (k) < hi_) { run_phase(*q, lds, (k)); if ((REPEAT_MASK >> (k)) & 1u) { xcd_barrier(xb); run_phase(*q, lds, (k)); } if ((k) + 1 < hi_) xcd_barrier(xb); } }
    PH(0) PH(1) PH(2) PH(3) PH(4) PH(5) PH(6) PH(7) PH(8) PH(9) PH(10) PH(11) PH(12) PH(13) PH(14) PH(15) PH(16) PH(17) PH(18) PH(20) PH(21) PH(22) PH(23) PH(24) PH(25)
#undef PH
}

#ifndef N_LAUNCH_MODE
#define N_LAUNCH_MODE 0
#endif

extern "C" void kernel_launch(void* const* d_in, const int* in_sizes, int n_in, void* d_out, int out_size, void* d_ws, size_t ws_size, hipStream_t stream) {
    static int grid = 0;
    if (grid == 0) {
        if (n_in != 36 || ws_size < WS_END) { fprintf(stderr, "kernel_launch: unexpected n_in %d / ws_size %zu (need %zu)\n", n_in, ws_size, (size_t)WS_END); grid = -1; return; }
        int dev = 0, cus = 0, per_cu = 0;
        hipGetDevice(&dev);
        hipDeviceGetAttribute(&cus, hipDeviceAttributeMultiprocessorCount, dev);
        if (hipFuncSetAttribute((const void*)mega_kernel, hipFuncAttributeMaxDynamicSharedMemorySize, LDS_BYTES) != hipSuccess) { fprintf(stderr, "hipFuncSetAttribute failed\n"); grid = -1; return; }
        if (hipOccupancyMaxActiveBlocksPerMultiprocessor(&per_cu, (const void*)mega_kernel, 512, LDS_BYTES) != hipSuccess || per_cu < 1) { fprintf(stderr, "occupancy query: %d\n", per_cu); per_cu = 1; }
        (void)hipGetLastError();
        grid = cus * 1;
    }
    if (grid < 0) return;
    Params p{};
    for (int i = 0; i < 36; ++i) p.in[i] = (const float*)d_in[i];
    p.out = (float*)d_out; p.ws = (unsigned char*)d_ws;
#if N_LAUNCH_MODE == 1
    for (int ph = 0; ph < NPHASE; ++ph) {
        p.ph_lo = ph; p.ph_hi = ph + 1;
        hipLaunchKernelGGL(mega_kernel, dim3(grid), dim3(512), LDS_BYTES, stream, p);
    }
#else
    p.ph_lo = 0; p.ph_hi = NPHASE;
    if (hipMemsetAsync((unsigned char*)d_ws + OFF_BAR, 0, XCD_BAR_WORDS * 4, stream) != hipSuccess) { fprintf(stderr, "memset failed\n"); return; }
    void* args[] = {&p};
    hipError_t e = hipLaunchCooperativeKernel((const void*)mega_kernel, dim3(grid), dim3(512), args, LDS_BYTES, stream);
    if (e != hipSuccess) fprintf(stderr, "cooperative launch failed: %s (grid %d)\n", hipGetErrorString(e), grid);
#endif
}
```

```cpp
#include <hip/hip_runtime.h>
#include <hip/hip_cooperative_groups.h>
#include <cstdio>
#include <cstdint>
namespace cg = cooperative_groups;

#define LAS __attribute__((address_space(3)))
typedef unsigned short bf16_t;
typedef short bf16x8 __attribute__((ext_vector_type(8)));
typedef float f32x4 __attribute__((ext_vector_type(4)));
typedef float f32x2 __attribute__((ext_vector_type(2)));
typedef unsigned u32x4 __attribute__((ext_vector_type(4)));
typedef unsigned u32x2 __attribute__((ext_vector_type(2)));

constexpr int T_ALL = 18432, T_LAT = 16384, DM = 1024, FF = 2816, SEQ = 2048, CTXL = 256, NB = 8;
constexpr int LDS_MAIN = 131072;
constexpr int LDS_BYTES = LDS_MAIN + 16;
constexpr int NPHASE = 26;
#define REPEAT_MASK 0u
constexpr size_t OFF_XS = 0;
constexpr size_t OFF_Y = OFF_XS + 8388608;
constexpr size_t OFF_H = OFF_Y + 37748736;
constexpr size_t OFF_BIG = OFF_H + 37748736;
constexpr size_t OFF_W = OFF_BIG + 113246208;
constexpr size_t OFF_MOD = OFF_W + 42991616;
constexpr size_t OFF_EXTRA = OFF_MOD + 663552;
constexpr size_t OFF_SP8 = OFF_EXTRA + 75497472;
constexpr size_t OFF_BAR = OFF_SP8 + 8192;
constexpr size_t WS_END = OFF_BAR + 16384;
constexpr size_t W_13_0 = 0, W_2_0 = 5767168, W_13_1 = 8650752, W_2_1 = 14417920, W_MIX = 17301504;
constexpr size_t W_HYIN = W_MIX, W_HYOUT = W_MIX + 3145728;
constexpr size_t W_RGIN = W_MIX, W_GATE = W_MIX + 2097152, W_RGOUT = W_MIX + 3145728;
constexpr size_t OFF_FILT = OFF_EXTRA;
constexpr size_t OFF_FILTC = OFF_EXTRA + 8388608;
constexpr size_t OFF_YP = OFF_EXTRA + 16777216;

#define PARG const __attribute__((address_space(4))) Params&
struct Params { const float* in[36]; float* out; unsigned char* ws; int ph_lo, ph_hi; };

__device__ __forceinline__ float bf2f(unsigned v) { return __uint_as_float(v << 16); }
__device__ __forceinline__ unsigned f2bf(float f) { unsigned u = __float_as_uint(f); u += 0x7FFFu + ((u >> 16) & 1u); return u >> 16; }
__device__ __forceinline__ unsigned cvt_pk_bf16(float lo, float hi) { unsigned r; asm volatile("v_cvt_pk_bf16_f32 %0, %1, %2" : "=v"(r) : "v"(lo), "v"(hi)); return r; }
__device__ __forceinline__ unsigned pack2(float lo, float hi) { return cvt_pk_bf16(lo, hi); }
__device__ __forceinline__ float sigmoidf_(float x) { return __builtin_amdgcn_rcpf(1.0f + __expf(-x)); }
__device__ __forceinline__ float siluf_(float x) { return x * __builtin_amdgcn_rcpf(1.0f + __expf(-x)); }
__device__ __forceinline__ float geluf_(float x) { const float u = 0.7978845608f * (x + 0.044715f * x * x * x); const float e = __expf(2.0f * u); const float t = 1.0f - 2.0f * __builtin_amdgcn_rcpf(e + 1.0f); return 0.5f * x * (1.0f + t); }
__device__ __forceinline__ float wave_sum(float v) {
#pragma unroll
    for (int o = 32; o > 0; o >>= 1) v += __shfl_xor(v, o, 64);
    return v;
}

namespace pg8 {
constexpr int BM = 256, BK = 64, HALF = 128, HTB = HALF * BK * 2, NXCD = 8, WGM = 8;
__host__ __device__ __forceinline__ int lds_byte(int r, int c) { const int st = (r >> 4) * 2 + (c >> 5), rr = r & 15, cc = c & 31, ob = rr * 64 + cc * 2; return st * 1024 + (ob ^ (((ob >> 9) & 1) << 5)); }
__host__ __device__ __forceinline__ void stage_rc(int b, int& R, int& C) { const int st = b / 1024, sb = b % 1024, swz = sb ^ (((sb >> 9) & 1) << 5); R = (st >> 1) * 16 + swz / 64; C = (st & 1) * 32 + (swz % 64) / 2; }
__host__ __device__ __forceinline__ int perm32(int rho) { const int n = rho >> 4, i = rho & 15; return 8 * (i >> 2) + 4 * n + (i & 3); }
struct Unit { int pm, pn, ks, nt, koff; };
struct Gemm { const bf16_t* A; const bf16_t* Bt; int M, N, K, lda, ldb, agrp, agoff; };
struct StaticOrder {
    int nM, nN, nwg, G, c, nctx, KS, ntt;
    __device__ void init(int M_main, int N, int K, int G_, int c_, int ctx_panels, int ks_) { nM = M_main / BM; nN = N / BM; nwg = nM * nN; G = G_; c = c_; nctx = ctx_panels; KS = ks_; ntt = K / BK; }
    __device__ bool next(int i, Unit& u) const {
        const long L = (long)i * G + c;
        if (L >= nwg) {
            int e = (int)(L - nwg); if (e >= nctx * nN * KS) return false;
            u.ks = e % KS; e /= KS; u.pn = e % nN; u.pm = 64 + e / nN; u.nt = ntt / KS; u.koff = u.ks * u.nt * BK; return true;
        }
        int wgid = (int)L; { const int q = nwg / NXCD, r = nwg % NXCD, xcd = wgid % NXCD, off = wgid / NXCD; wgid = (xcd < r ? xcd * (q + 1) : r * (q + 1) + (xcd - r) * q) + off; }
        const int nig = WGM * nN, gid = wgid / nig, fm = gid * WGM, gsz = (nM - fm) < WGM ? (nM - fm) : WGM;
        u.pm = fm + ((wgid % nig) % gsz); u.pn = (wgid % nig) / gsz; u.ks = 0; u.nt = ntt; u.koff = 0; return true;
    }
};

template <class Epi>
__device__ __forceinline__ void gemm_phase(LAS unsigned char* lds, const Gemm g, const StaticOrder& S, const Epi& E) {
    const int tid = threadIdx.x, wid = __builtin_amdgcn_readfirstlane(tid >> 6), lane = tid & 63, wr = wid >> 2, wc = wid & 3, fr = lane & 15, fq = lane >> 4;
    unsigned voffA[2], voffB[2];
#pragma unroll
    for (int i = 0; i < 2; ++i) { int R, C; stage_rc(tid * 16 + i * 8192, R, C); const int Rb = Epi::PERM ? ((R & ~31) + perm32(R & 31)) : R;
        voffA[i] = (unsigned)(R * g.lda + C) * 2u; voffB[i] = (unsigned)(Rb * g.ldb + C) * 2u; }
    const size_t kstep = (size_t)(BK * 2);
    const size_t hstepA = (size_t)HALF * g.lda * 2, hstepB = (size_t)HALF * g.ldb * 2;
    const size_t tstepA = 2 * hstepA, tstepB = 2 * hstepB;
    const unsigned ldsw = (unsigned)wid * 1024u;
    const int aoff = lds_byte(wr * 64 + fr, fq * 8), boff = lds_byte(wc * 32 + fr, fq * 8);
#define PG8_SA(b, h) (((b) * 2 + (h)) * HTB)
#define PG8_SB(b, h) ((4 + (b) * 2 + (h)) * HTB)
#define PG8_STAGE(bufoff, gbase, voff) do { _Pragma("unroll") for (int _i = 0; _i < 2; ++_i) \
        __builtin_amdgcn_global_load_lds((const unsigned*)((const char*)(gbase) + (voff)[_i]), (LAS unsigned*)(lds + (bufoff) + ldsw + _i * 8192), 16, 0, 0); } while (0)
#define PG8_LDA(dst, b, h) do { _Pragma("unroll") for (int m = 0; m < 4; ++m) _Pragma("unroll") for (int k = 0; k < 2; ++k) dst[m][k] = *(const LAS bf16x8*)(lds + PG8_SA(b, h) + aoff + m * 2048 + k * 1024); } while (0)
#define PG8_LDB(dst, b, h) do { _Pragma("unroll") for (int n = 0; n < 2; ++n) _Pragma("unroll") for (int k = 0; k < 2; ++k) dst[n][k] = *(const LAS bf16x8*)(lds + PG8_SB(b, h) + boff + n * 2048 + k * 1024); } while (0)
#define PG8_MMA(ai, bj, At, Bt) do { __builtin_amdgcn_s_setprio(1); _Pragma("unroll") for (int m = 0; m < 4; ++m) _Pragma("unroll") for (int n = 0; n < 2; ++n) _Pragma("unroll") for (int k = 0; k < 2; ++k) \
        acc[ai][bj][m][n] = __builtin_amdgcn_mfma_f32_16x16x32_bf16(Bt[n][k], At[m][k], acc[ai][bj][m][n], 0, 0, 0); __builtin_amdgcn_s_setprio(0); } while (0)
#define PG8_WAIT_V(n) asm volatile("s_waitcnt vmcnt(" #n ")" ::: "memory")
#define PG8_WAIT_L(n) asm volatile("s_waitcnt lgkmcnt(" #n ")" ::: "memory")
#define PG8_BAR __builtin_amdgcn_s_barrier()
#define PG8_SCHED __builtin_amdgcn_sched_barrier(0)
#define PG8_UA(u) ((const char*)g.A + (size_t)(u).pm * tstepA + (size_t)((u).pn / g.agrp) * (size_t)g.agoff * 2 + (size_t)(u).koff * 2)
#define PG8_UB(u) ((const char*)g.Bt + (size_t)(u).pn * tstepB + (size_t)(u).koff * 2)
    Unit cur, nxt; int ui = 0;
    if (!S.next(0, cur)) return;
    f32x4 acc[2][2][4][2];
#pragma unroll
    for (int a = 0; a < 2; ++a)
#pragma unroll
        for (int b = 0; b < 2; ++b)
#pragma unroll
            for (int m = 0; m < 4; ++m)
#pragma unroll
                for (int n = 0; n < 2; ++n) acc[a][b][m][n] = (f32x4){0.f, 0.f, 0.f, 0.f};
    bf16x8 At[4][2], B0[2][2], B1[2][2];
    const char* cA = PG8_UA(cur); const char* cB = PG8_UB(cur);
    PG8_STAGE(PG8_SB(0, 0), cB, voffB); PG8_STAGE(PG8_SA(0, 0), cA, voffA); PG8_STAGE(PG8_SB(0, 1), cB + hstepB, voffB); PG8_STAGE(PG8_SA(0, 1), cA + hstepA, voffA);
    if (wr == 1) PG8_BAR;
    PG8_WAIT_V(4); PG8_BAR;
    PG8_STAGE(PG8_SB(1, 0), cB + kstep, voffB); PG8_STAGE(PG8_SA(1, 0), cA + kstep, voffA); PG8_STAGE(PG8_SB(1, 1), cB + hstepB + kstep, voffB);
    PG8_WAIT_V(6); PG8_BAR;
    for (;;) {
        const bool has_next = S.next(ui + 1, nxt);
        const char* nA = has_next ? PG8_UA(nxt) : cA; const char* nB = has_next ? PG8_UB(nxt) : cB;
        const int nt = cur.nt;
        for (int t = 0; t < nt; t += 2) {
            const bool last = (t == nt - 2);
            const char* a1 = cA + (size_t)(t + 1) * kstep;
            const char* a2 = last ? nA : cA + (size_t)(t + 2) * kstep; const char* b2 = last ? nB : cB + (size_t)(t + 2) * kstep;
            const char* a3 = a2 + kstep; const char* b3 = b2 + kstep;
            PG8_LDB(B0, 0, 0); PG8_SCHED; PG8_LDA(At, 0, 0); PG8_STAGE(PG8_SA(1, 1), a1 + hstepA, voffA);
            PG8_WAIT_L(8); PG8_BAR; PG8_WAIT_L(0); PG8_MMA(0, 0, At, B0); PG8_BAR; PG8_SCHED;
            PG8_LDB(B1, 0, 1); PG8_STAGE(PG8_SB(0, 0), b2, voffB);
            PG8_BAR; PG8_WAIT_L(0); PG8_MMA(0, 1, At, B1); PG8_BAR;
            PG8_LDA(At, 0, 1); PG8_STAGE(PG8_SA(0, 0), a2, voffA);
            PG8_BAR; PG8_WAIT_L(0); PG8_MMA(1, 0, At, B0); PG8_BAR; PG8_SCHED;
            PG8_STAGE(PG8_SB(0, 1), b2 + hstepB, voffB);
            PG8_WAIT_V(6); PG8_BAR; PG8_MMA(1, 1, At, B1); PG8_BAR;
            PG8_LDB(B0, 1, 0); PG8_SCHED; PG8_LDA(At, 1, 0); PG8_STAGE(PG8_SA(0, 1), a2 + hstepA, voffA);
            PG8_WAIT_L(8); PG8_BAR; PG8_WAIT_L(0); PG8_MMA(0, 0, At, B0); PG8_BAR; PG8_SCHED;
            PG8_LDB(B1, 1, 1); PG8_STAGE(PG8_SB(1, 0), b3, voffB);
            PG8_BAR; PG8_WAIT_L(0); PG8_MMA(0, 1, At, B1); PG8_BAR;
            PG8_LDA(At, 1, 1); PG8_STAGE(PG8_SA(1, 0), a3, voffA);
            PG8_BAR; PG8_WAIT_L(0); PG8_MMA(1, 0, At, B0); PG8_BAR; PG8_SCHED;
            PG8_STAGE(PG8_SB(1, 1), b3 + hstepB, voffB);
            PG8_WAIT_V(6); PG8_BAR; PG8_MMA(1, 1, At, B1); PG8_BAR;
        }
        E(acc, cur, wr, wc, fr, fq);
        if (!has_next) break;
#pragma unroll
        for (int a = 0; a < 2; ++a)
#pragma unroll
            for (int b = 0; b < 2; ++b)
#pragma unroll
                for (int m = 0; m < 4; ++m)
#pragma unroll
                    for (int n = 0; n < 2; ++n) acc[a][b][m][n] = (f32x4){0.f, 0.f, 0.f, 0.f};
        cur = nxt; cA = nA; cB = nB; ++ui;
    }
    PG8_WAIT_V(0);
    if (wr == 0) PG8_BAR;
    PG8_BAR;
#undef PG8_SA
#undef PG8_SB
#undef PG8_STAGE
#undef PG8_LDA
#undef PG8_LDB
#undef PG8_MMA
#undef PG8_WAIT_V
#undef PG8_WAIT_L
#undef PG8_BAR
#undef PG8_SCHED
#undef PG8_UA
#undef PG8_UB
}

struct EpiSwiglu {
    static constexpr bool PERM = true;
    bf16_t* O;
    __device__ __forceinline__ void operator()(const f32x4 (&acc)[2][2][4][2], const Unit& u, int wr, int wc, int fr, int fq) const {
        const int row0 = u.pm * BM + wr * 64 + fr, col0 = u.pn * 128 + wc * 32 + 8 * fq;
#pragma unroll
        for (int ai = 0; ai < 2; ++ai)
#pragma unroll
            for (int m = 0; m < 4; ++m) {
                bf16_t* rowp = O + (size_t)(row0 + ai * HALF + m * 16) * FF + col0;
                float v[8];
#pragma unroll
                for (int n = 0; n < 2; ++n)
#pragma unroll
                    for (int j = 0; j < 4; ++j) v[n * 4 + j] = siluf_(acc[ai][0][m][n][j]) * acc[ai][1][m][n][j];
                u32x4 w; w.x = cvt_pk_bf16(v[0], v[1]); w.y = cvt_pk_bf16(v[2], v[3]); w.z = cvt_pk_bf16(v[4], v[5]); w.w = cvt_pk_bf16(v[6], v[7]);
                *(u32x4*)rowp = w;
            }
    }
};
struct EpiBf16 {
    static constexpr bool PERM = true;
    bf16_t* O; int ldc; const float* cbias; const float* rbias; int split_cols; size_t split_stride; bf16_t* P;
    __device__ __forceinline__ void operator()(const f32x4 (&acc)[2][2][4][2], const Unit& u, int wr, int wc, int fr, int fq) const {
        const int row0 = u.pm * BM + wr * 64 + fr; int colt = u.pn * BM; bf16_t* base = O;
        const bool part = u.ks > 0;
        if (part) base = P + (size_t)(u.ks - 1) * (2048 * DM) - (size_t)T_LAT * ldc;
        if (split_cols) { const int t = colt / split_cols; base += (size_t)t * split_stride; colt -= t * split_cols; }
        const int col0 = colt + wc * 32 + 8 * fq, bcol0 = u.pn * BM + wc * 32 + 8 * fq;
        f32x4 bv[2][2];
#pragma unroll
        for (int bj = 0; bj < 2; ++bj)
#pragma unroll
            for (int n = 0; n < 2; ++n) bv[bj][n] = (cbias && !part) ? *(const f32x4*)(cbias + bcol0 + bj * HALF + 4 * n) : (f32x4){0.f, 0.f, 0.f, 0.f};
#pragma unroll
        for (int ai = 0; ai < 2; ++ai)
#pragma unroll
            for (int m = 0; m < 4; ++m) {
                const int row = row0 + ai * HALF + m * 16;
                const float rb = rbias ? rbias[row] : 0.f;
                bf16_t* rowp = base + (size_t)row * ldc + col0;
#pragma unroll
                for (int bj = 0; bj < 2; ++bj) { f32x4 v0 = acc[ai][bj][m][0] + bv[bj][0] + rb, v1 = acc[ai][bj][m][1] + bv[bj][1] + rb;
                    u32x4 w; w.x = cvt_pk_bf16(v0[0], v0[1]); w.y = cvt_pk_bf16(v0[2], v0[3]); w.z = cvt_pk_bf16(v1[0], v1[1]); w.w = cvt_pk_bf16(v1[2], v1[3]);
                    *(u32x4*)(rowp + bj * HALF) = w; }
            }
    }
};
__device__ __forceinline__ float dpp_shr(float oldv, float v, int sh) {
    int r;
    switch (sh) {
    case 1: r = __builtin_amdgcn_update_dpp(__float_as_int(oldv), __float_as_int(v), 0x111, 0xf, 0xf, false); break;
    case 2: r = __builtin_amdgcn_update_dpp(__float_as_int(oldv), __float_as_int(v), 0x112, 0xf, 0xf, false); break;
    case 4: r = __builtin_amdgcn_update_dpp(__float_as_int(oldv), __float_as_int(v), 0x114, 0xf, 0xf, false); break;
    default: r = __builtin_amdgcn_update_dpp(__float_as_int(oldv), __float_as_int(v), 0x118, 0xf, 0xf, false); break;
    }
    return __int_as_float(r);
}
__device__ __forceinline__ float dpp_shl(float oldv, float v, int sh) {
    int r;
    switch (sh) {
    case 1: r = __builtin_amdgcn_update_dpp(__float_as_int(oldv), __float_as_int(v), 0x101, 0xf, 0xf, false); break;
    case 2: r = __builtin_amdgcn_update_dpp(__float_as_int(oldv), __float_as_int(v), 0x102, 0xf, 0xf, false); break;
    case 4: r = __builtin_amdgcn_update_dpp(__float_as_int(oldv), __float_as_int(v), 0x104, 0xf, 0xf, false); break;
    default: r = __builtin_amdgcn_update_dpp(__float_as_int(oldv), __float_as_int(v), 0x108, 0xf, 0xf, false); break;
    }
    return __int_as_float(r);
}
struct EpiGate {
    static constexpr bool PERM = false;
    unsigned* GA0; unsigned* GA1; const bf16_t* XC; const float* ba; const float* bi; const float* lam; f32x2* AGG;
    __device__ __forceinline__ void operator()(const f32x4 (&acc)[2][2][4][2], const Unit& u, int wr, int wc, int fr, int fq) const {
        const int row0 = u.pm * BM + wr * 64 + fr;
        const int ch0 = (u.pn >> 2) * 256 + (u.pn & 3) * 64 + wc * 16 + fq * 4;
        const bool isctx = u.pm >= 64;
        const int bseq = isctx ? (u.pm - 64) : (u.pm >> 3);
#pragma unroll
        for (int d = 0; d < 2; ++d) {
            unsigned* GA = d ? GA1 : GA0;
#pragma unroll
            for (int ai = 0; ai < 2; ++ai) {
                float Aq[4], Bq[4];
#pragma unroll
                for (int j = 0; j < 4; ++j) { Aq[j] = 1.f; Bq[j] = 0.f; }
#pragma unroll
                for (int m0 = 0; m0 < 4; ++m0) {
                    const int m = d ? 3 - m0 : m0;
                    const int row = row0 + ai * HALF + m * 16;
                    const f32x4 bav = *(const f32x4*)(ba + d * DM + ch0), biv = *(const f32x4*)(bi + d * DM + ch0), spv = *(const f32x4*)(lam + d * DM + ch0);
                    const u32x2 xr = *(const u32x2*)(XC + (size_t)row * DM + ch0);
                    const float xc[4] = {bf2f(xr.x & 0xffffu), bf2f(xr.x >> 16), bf2f(xr.y & 0xffffu), bf2f(xr.y >> 16)};
                    u32x4 w; float av[4];
#pragma unroll
                    for (int j = 0; j < 4; ++j) {
                        const float rr = sigmoidf_(acc[ai][d][m][0][j] + bav[j]);
                        const float ii = sigmoidf_(acc[ai][d][m][1][j] + biv[j]);
                        const float la = rr * spv[j];
                        const float ar = __expf(bf2f(cvt_pk_bf16(la, 0.f) & 0xffffu));
                        av[j] = ar;
                        const float bb = __builtin_amdgcn_sqrtf(fmaxf(1.0f - ar * ar, 0.f)) * ii * xc[j];
                        w[j] = cvt_pk_bf16(la, bb);
                    }
                    *(u32x4*)(GA + (size_t)row * DM + ch0) = w;
#pragma unroll
                    for (int j = 0; j < 4; ++j) {
                        float a = av[j], b = bf2f(w[j] >> 16);
#pragma unroll
                        for (int sh = 1; sh < 16; sh <<= 1) {
                            const float ap = d ? dpp_shl(1.f, a, sh) : dpp_shr(1.f, a, sh);
                            const float bp = d ? dpp_shl(0.f, b, sh) : dpp_shr(0.f, b, sh);
                            b = a * bp + b; a = a * ap;
                        }
                        Bq[j] = a * Bq[j] + b; Aq[j] = a * Aq[j];
                    }
                    asm volatile("" ::: "memory");
                }
                if (fr == (d ? 0 : 15)) {
                    const int c64 = 2 * ai + wr;
                    int k;
                    if (isctx) k = d ? 3 - c64 : c64;
                    else { const int kl = (u.pm & 7) * 4 + c64; k = 4 + (d ? 31 - kl : kl); }
                    f32x2* dst = AGG + (((size_t)d * 8 + bseq) * 36 + k) * DM + ch0;
                    *(f32x4*)dst = (f32x4){Aq[0], Bq[0], Aq[1], Bq[1]};
                    *(f32x4*)(dst + 2) = (f32x4){Aq[2], Bq[2], Aq[3], Bq[3]};
                }
            }
        }
    }
};
}

__device__ __forceinline__ void convT_tile(LAS unsigned char* lds, const float* src, int N, int K, bf16_t* dst, int mode, int aux, int tile) {
    LAS float* t = (LAS float*)lds;
    const int ntn = N / 256, tk = tile / ntn, tn = tile % ntn, k0 = tk * 64, n0 = tn * 256, tid = threadIdx.x;
    {
        const int kk = tid >> 6, n4 = (tid & 63) * 4;
        f32x4 v[8];
#pragma unroll
        for (int i = 0; i < 8; ++i) v[i] = *(const f32x4*)(src + (size_t)(k0 + kk + 8 * i) * N + n0 + n4);
#pragma unroll
        for (int i = 0; i < 8; ++i)
#pragma unroll
            for (int j = 0; j < 4; ++j) t[(kk + 8 * i) * 257 + n4 + j] = v[i][j];
    }
    __syncthreads();
#pragma unroll
    for (int i = 0; i < 4; ++i) {
        const int pi = tid + 512 * i, n = pi >> 3, k8 = (pi & 7) * 8, ng = n0 + n;
        int row;
        if (mode == 0) row = ng;
        else if (mode == 1) row = (ng >> 7) * 256 + (ng & 127);
        else if (mode == 2) row = (ng >> 7) * 256 + 128 + (ng & 127);
        else { const int d = aux & 1, gate = (aux >> 1) & 1, h = aux >> 2; const int pn = 4 * h + (ng >> 6), q = ng & 63;
               row = 256 * pn + 128 * d + 32 * (q >> 4) + 16 * gate + (q & 15); }
        float v[8];
#pragma unroll
        for (int j = 0; j < 8; ++j) v[j] = t[(k8 + j) * 257 + n];
        u32x4 w; w.x = pack2(v[0], v[1]); w.y = pack2(v[2], v[3]); w.z = pack2(v[4], v[5]); w.w = pack2(v[6], v[7]);
        *(u32x4*)(dst + (size_t)row * K + k0 + k8) = w;
    }
    __syncthreads();
}

__device__ __forceinline__ int conv_items(PARG p, LAS unsigned char* lds, int layer, int set, int tile) {
    bf16_t* W = (bf16_t*)(p.ws + OFF_W);
    int base = 0;
#define CONV_MAT(SRC, NN, KK, DST, MODE, AUX) { const int cnt = ((NN) / 256) * ((KK) / 64); if (tile >= base && tile < base + cnt) { convT_tile(lds, (SRC), (NN), (KK), (DST), (MODE), (AUX), tile - base); return -1; } base += cnt; }
    if (set == 0) {
        const size_t o = ((size_t)layer * 2 + 0) * DM * FF;
        CONV_MAT(p.in[7] + o, FF, DM, W + W_13_0, 1, 0)
        CONV_MAT(p.in[8] + o, FF, DM, W + W_13_0, 2, 0)
    } else {
        const size_t o0 = ((size_t)layer * 2 + 0) * DM * FF, o1 = ((size_t)layer * 2 + 1) * DM * FF;
        CONV_MAT(p.in[9] + o0, DM, FF, W + W_2_0, 0, 0)
        if (layer == 0) {
            CONV_MAT(p.in[10], 3 * DM, DM, W + W_HYIN, 0, 0)
            CONV_MAT(p.in[23], DM, DM, W + W_HYOUT, 0, 0)
        } else {
            CONV_MAT(p.in[25], 2 * DM, DM, W + W_RGIN, 0, 0)
            for (int d = 0; d < 2; ++d) for (int h = 0; h < 4; ++h) {
                CONV_MAT(p.in[29] + ((size_t)d * 4 + h) * 65536, 256, 256, W + W_GATE, 3, d | (0 << 1) | (h << 2))
                CONV_MAT(p.in[31] + ((size_t)d * 4 + h) * 65536, 256, 256, W + W_GATE, 3, d | (1 << 1) | (h << 2))
            }
            CONV_MAT(p.in[34], DM, DM, W + W_RGOUT, 0, 0)
        }
        CONV_MAT(p.in[7] + o1, FF, DM, W + W_13_1, 1, 0)
        CONV_MAT(p.in[8] + o1, FF, DM, W + W_13_1, 2, 0)
        CONV_MAT(p.in[9] + o1, DM, FF, W + W_2_1, 0, 0)
    }
#undef CONV_MAT
    return base;
}
__device__ __forceinline__ void convert_weights(PARG p, LAS unsigned char* lds, int layer, int set, int first_blk) {
    const int total = conv_items(p, lds, layer, set, -1);
    const int nb = (int)gridDim.x - first_blk;
    if ((int)blockIdx.x < first_blk) return;
    for (int t = (int)blockIdx.x - first_blk; t < total; t += nb) conv_items(p, lds, layer, set, t);
}

__device__ __forceinline__ void ada_phase(PARG p, LAS unsigned char* lds) {
    LAS float* sc = (LAS float*)lds;
    LAS float* red = sc + 9 * 1024;
    const int tid = threadIdx.x;
    bool loaded = false;
    float* MOD = (float*)(p.ws + OFF_MOD);
    for (int item = blockIdx.x; item < 288; item += gridDim.x) {
        if (!loaded) {
            for (int i = tid; i < 9 * 1024; i += 512) { const float v = (i < 8192) ? p.in[1][i] : p.in[3][i - 8192]; sc[i] = siluf_(v); }
            __syncthreads(); loaded = true;
        }
        const int l = item / 144, n0 = (item % 144) * 64, kc = tid >> 6, col = tid & 63;
        const float* w = p.in[4] + (size_t)l * DM * 9216 + n0 + col;
        float a[9];
#pragma unroll
        for (int m = 0; m < 9; ++m) a[m] = 0.f;
#pragma unroll 1
        for (int k0 = kc * 128; k0 < kc * 128 + 128; k0 += 32) {
            float wv[32];
#pragma unroll
            for (int i = 0; i < 32; ++i) wv[i] = w[(size_t)(k0 + i) * 9216];
#pragma unroll
            for (int i = 0; i < 32; ++i)
#pragma unroll
                for (int m = 0; m < 9; ++m) a[m] += sc[m * 1024 + k0 + i] * wv[i];
        }
#pragma unroll
        for (int m = 0; m < 9; ++m) red[(kc * 9 + m) * 64 + col] = a[m];
        __syncthreads();
        for (int i = tid; i < 9 * 64; i += 512) {
            const int m = i >> 6, c2 = i & 63; float s = 0.f;
#pragma unroll
            for (int q = 0; q < 8; ++q) s += red[(q * 9 + m) * 64 + c2];
            MOD[((size_t)l * 9 + m) * 9216 + n0 + c2] = s + p.in[5][(size_t)l * 9216 + n0 + c2];
        }
        __syncthreads();
    }
    __syncthreads();
}

__device__ __forceinline__ void filter_item(PARG p, LAS unsigned char* lds, int L, int k0, bf16_t* FT, int ldq) {
    LAS float* zf = (LAS float*)lds;
    LAS float* hA = zf + 16 * 64;
    LAS float* hB = hA + 16 * 64;
    LAS float* W0 = hB + 16 * 64;
    LAS float* W1 = W0 + 33 * 64;
    LAS float* W2 = W1 + 64 * 64;
    const int tid = threadIdx.x, w = tid >> 6, lane = tid & 63;
    const float* fb0 = p.in[15]; const float* fb1 = p.in[17]; const float* fb2 = p.in[19]; const float* freq = p.in[20]; const float* fwout = p.in[21];
    for (int i = tid; i < 33 * 64; i += 512) W0[i] = p.in[14][i];
    for (int i = tid; i < 64 * 64; i += 512) { W1[i] = p.in[16][i]; W2[i] = p.in[18][i]; }
#pragma unroll 1
    for (int pp = 0; pp < 2; ++pp) {
        const int pi = w * 2 + pp, k = k0 + pi;
        float f = 0.f;
        if (lane == 0) f = (float)k / (float)(L - 1);
        else if (lane < 33) {
            const int band = (lane - 1) & 15;
            const float fr = 1e-4f + (float)band * ((15.0f - 1e-4f) / 15.0f);
            const float wk = 6.283185307179586f * (float)k / (float)L;
            const float ph = fr * wk;
            f = (lane <= 16) ? cosf(ph) : -sinf(ph);
        }
        zf[pi * 64 + lane] = f;
    }
    __syncthreads();
    {
        const float b0 = fb0[lane], f0 = freq[lane];
        float a0 = b0, a1 = b0;
#pragma unroll 11
        for (int e = 0; e < 33; ++e) { const float wv = W0[e * 64 + lane]; a0 += zf[(w * 2) * 64 + e] * wv; a1 += zf[(w * 2 + 1) * 64 + e] * wv; }
        hA[(w * 2) * 64 + lane] = sinf(f0 * a0); hA[(w * 2 + 1) * 64 + lane] = sinf(f0 * a1);
    }
    __syncthreads();
    {
        const float b0 = fb1[lane], f0 = freq[64 + lane];
        float a0 = b0, a1 = b0;
#pragma unroll 16
        for (int e = 0; e < 64; ++e) { const float wv = W1[e * 64 + lane]; a0 += hA[(w * 2) * 64 + e] * wv; a1 += hA[(w * 2 + 1) * 64 + e] * wv; }
        hB[(w * 2) * 64 + lane] = sinf(f0 * a0); hB[(w * 2 + 1) * 64 + lane] = sinf(f0 * a1);
    }
    __syncthreads();
    {
        const float b0 = fb2[lane], f0 = freq[128 + lane];
        float a0 = b0, a1 = b0;
#pragma unroll 16
        for (int e = 0; e < 64; ++e) { const float wv = W2[e * 64 + lane]; a0 += hB[(w * 2) * 64 + e] * wv; a1 += hB[(w * 2 + 1) * 64 + e] * wv; }
        __syncthreads();
        hA[(w * 2) * 64 + lane] = sinf(f0 * a0); hA[(w * 2 + 1) * 64 + lane] = sinf(f0 * a1);
    }
    __syncthreads();
    const float min_decay = -3.0701134573253945f, max_decay = -15.350567286626973f;
#pragma unroll 1
    for (int q = 0; q < 4; ++q) {
        const int n = tid + 512 * q;
        float acc[16];
#pragma unroll
        for (int i = 0; i < 16; ++i) acc[i] = 0.f;
#pragma unroll 1
        for (int e0 = 0; e0 < 64; e0 += 32) {
            float wv[32];
#pragma unroll
            for (int e = 0; e < 32; ++e) wv[e] = fwout[(e0 + e) * 2048 + n];
#pragma unroll
            for (int e = 0; e < 32; ++e)
#pragma unroll
                for (int i = 0; i < 16; ++i) acc[i] += hA[i * 64 + e0 + e] * wv[e];
        }
        const int c = n & 1023; const bool bwd = n >= 1024;
        const float delta = fabsf(min_decay + (float)c * ((max_decay - min_decay) / 1023.0f));
        bf16_t* dst = FT + (size_t)c * ldq;
#pragma unroll
        for (int i = 0; i < 16; ++i) {
            const int k = k0 + i;
            const float tk = (float)k / (float)(L - 1);
            const float val = acc[i] * __expf(-tk * delta);
            if (!bwd) dst[(L - 1) - k] = (bf16_t)f2bf(val);
            else if (k >= 1) dst[(L - 1) + k] = (bf16_t)f2bf(val);
        }
        if (k0 == 0 && !bwd) dst[2 * L - 1] = 0;
    }
    __syncthreads();
}
__device__ __forceinline__ void filter_phase(PARG p, LAS unsigned char* lds) {
    for (int item = (int)gridDim.x - 1 - (int)blockIdx.x; item < 144; item += gridDim.x) {
        if (item < 128) filter_item(p, lds, SEQ, item * 16, (bf16_t*)(p.ws + OFF_FILT), 4096);
        else filter_item(p, lds, CTXL, (item - 128) * 16, (bf16_t*)(p.ws + OFF_FILTC), 512);
    }
}

struct EwArgs { int init; int has_h; int nrows; float coef; int lres, gate_i, gpost_i; int lh, gpre_i, shift_i, scale_i; int nks; };
__device__ __forceinline__ void ew_phase(PARG p, const EwArgs a) {
    const int lane = threadIdx.x & 63, wv = threadIdx.x >> 6;
    const float* MOD = (const float*)(p.ws + OFF_MOD);
    const float* NG = p.in[6];
    const bf16_t* Y = (const bf16_t*)(p.ws + OFF_Y);
    bf16_t* H = (bf16_t*)(p.out);
    for (int row = blockIdx.x * 8 + wv; row < a.nrows; row += gridDim.x * 8) {
        const int midx = row < T_LAT ? (row >> 11) : 8;
        bf16_t* xp = (bf16_t*)(p.ws + OFF_H) + (size_t)row * DM;
        f32x4 x[4], g[4], sh[4], scl[4];
        if (a.has_h) {
#pragma unroll
            for (int q = 0; q < 4; ++q) {
                const int col = q * 256 + lane * 4;
                g[q] = *(const f32x4*)(NG + ((size_t)a.lh * 6 + a.gpre_i) * DM + col);
                sh[q] = *(const f32x4*)(MOD + ((size_t)a.lh * 9 + midx) * 9216 + a.shift_i * DM + col);
                scl[q] = *(const f32x4*)(MOD + ((size_t)a.lh * 9 + midx) * 9216 + a.scale_i * DM + col);
            }
        }
        if (a.init) {
            if (row < T_LAT) {
                const int t = row & (SEQ - 1); const float pr = (float)(t >> 6), pc = (float)(t & 63);
#pragma unroll
                for (int q = 0; q < 4; ++q) {
                    const int col = q * 256 + lane * 4;
                    f32x4 v = *(const f32x4*)(p.in[0] + (size_t)row * DM + col);
#pragma unroll
                    for (int j = 0; j < 4; ++j) {
                        const int d = col + j, i = d & 255;
                        const float om = __expf(-(float)i * (9.210340371976184f / 256.0f));
                        const float ang = ((d < 512) ? pr : pc) * om;
                        v[j] += ((d >> 8) & 1) ? __cosf(ang) : __sinf(ang);
                    }
                    x[q] = v;
                }
            } else {
#pragma unroll
                for (int q = 0; q < 4; ++q) x[q] = *(const f32x4*)(p.in[2] + (size_t)(row - T_LAT) * DM + q * 256 + lane * 4);
            }
        } else {
            f32x4 y[4], gt[4], gp[4]; u32x2 yr[4]; float ss = 0.f;
#pragma unroll
            for (int q = 0; q < 4; ++q) {
                const int col = q * 256 + lane * 4;
                { const u32x2 xv = *(const u32x2*)(xp + col); x[q] = (f32x4){bf2f(xv.x & 0xffffu), bf2f(xv.x >> 16), bf2f(xv.y & 0xffffu), bf2f(xv.y >> 16)}; }
                yr[q] = *(const u32x2*)(Y + (size_t)row * DM + col);
                gt[q] = *(const f32x4*)(MOD + ((size_t)a.lres * 9 + midx) * 9216 + a.gate_i * DM + col);
                gp[q] = *(const f32x4*)(NG + ((size_t)a.lres * 6 + a.gpost_i) * DM + col);
            }
#pragma unroll
            for (int q = 0; q < 4; ++q) {
                y[q] = (f32x4){bf2f(yr[q].x & 0xffffu), bf2f(yr[q].x >> 16), bf2f(yr[q].y & 0xffffu), bf2f(yr[q].y >> 16)};
                if (row >= T_LAT) for (int k = 0; k + 1 < a.nks; ++k) {
                    const u32x2 pr2 = *(const u32x2*)((const bf16_t*)(p.ws + OFF_YP) + ((size_t)k * 2048 + (row - T_LAT)) * DM + q * 256 + lane * 4);
                    y[q] = y[q] + (f32x4){bf2f(pr2.x & 0xffffu), bf2f(pr2.x >> 16), bf2f(pr2.y & 0xffffu), bf2f(pr2.y >> 16)};
                }
#pragma unroll
                for (int j = 0; j < 4; ++j) ss += y[q][j] * y[q][j];
            }
            ss = wave_sum(ss);
            const float r = a.coef * rsqrtf(ss * (1.0f / DM) + 1e-6f);
#pragma unroll
            for (int q = 0; q < 4; ++q) x[q] = x[q] + (r * gt[q]) * (y[q] * gp[q]);
        }
        if (!a.has_h) {
#pragma unroll
            for (int q = 0; q < 4; ++q) *(f32x4*)(p.out + (size_t)row * DM + q * 256 + lane * 4) = x[q];
        } else {
#pragma unroll
            for (int q = 0; q < 4; ++q) { u32x2 w; w.x = pack2(x[q][0], x[q][1]); w.y = pack2(x[q][2], x[q][3]); *(u32x2*)(xp + q * 256 + lane * 4) = w; }
        }
        if (a.has_h) {
            float ss = 0.f;
#pragma unroll
            for (int q = 0; q < 4; ++q)
#pragma unroll
                for (int j = 0; j < 4; ++j) ss += x[q][j] * x[q][j];
            ss = wave_sum(ss);
            const float r = rsqrtf(ss * (1.0f / DM) + 1e-6f);
#pragma unroll
            for (int q = 0; q < 4; ++q) {
                const int col = q * 256 + lane * 4;
                const f32x4 h = (x[q] * r) * g[q] * (scl[q] + 1.0f) + sh[q];
                u32x2 w; w.x = pack2(h[0], h[1]); w.y = pack2(h[2], h[3]);
                *(u32x2*)(H + (size_t)row * DM + col) = w;
            }
        }
    }
}

template <int L>
__device__ __forceinline__ void longconv_channel(PARG p, LAS unsigned char* lds, int c) {
    constexpr int NBLK = L / 64, NCOL = NBLK * 8, FLEN = 2 * L, CSTRIDE = FLEN * 2 + 32, ZSTRIDE = 144;
    constexpr int Z_OFF = 8 * CSTRIDE;
    constexpr int MB = (L == SEQ) ? 4 : 1, CBW = (L == SEQ) ? 2 : 1;
    static_assert(Z_OFF + NCOL * ZSTRIDE <= LDS_MAIN, "lds");
    const int tid = threadIdx.x, wid = tid >> 6, lane = tid & 63, fr = lane & 15, fq = lane >> 4;
    const int tok0 = (L == SEQ) ? 0 : T_LAT;
    const bf16_t* UT = (const bf16_t*)(p.ws + OFF_BIG);
    const bf16_t* FT = (L == SEQ) ? (const bf16_t*)(p.ws + OFF_FILT) + (size_t)c * 4096 : (const bf16_t*)(p.ws + OFF_FILTC) + (size_t)c * 512;
    bf16_t* YT = (bf16_t*)(p.ws + OFF_Y);
    const float* cw = p.in[12]; const float* cb = p.in[13];
    for (int v = tid; v < FLEN / 8; v += 512) *(LAS u32x4*)(lds + v * 16) = *(const u32x4*)(FT + v * 8);
    {
        const float w10 = cw[0 * 3072 + 1024 + c], w11 = cw[1 * 3072 + 1024 + c], w12 = cw[2 * 3072 + 1024 + c], b1 = cb[1024 + c];
        const float w20 = cw[0 * 3072 + 2048 + c], w21 = cw[1 * 3072 + 2048 + c], w22 = cw[2 * 3072 + 2048 + c], b2 = cb[2048 + c];
        const bf16_t* r1 = UT + (size_t)(1024 + c) * T_ALL + tok0; const bf16_t* r2 = UT + (size_t)(2048 + c) * T_ALL + tok0;
#pragma unroll
        for (int it = 0; it < (NB * L / 8 + 511) / 512; ++it) {
            const int g = tid + it * 512;
            if (g >= NB * L / 8) break;
            const int b = g / (L / 8), t0 = (g % (L / 8)) * 8;
            const size_t o = (size_t)b * L + t0;
            const u32x4 a = *(const u32x4*)(r1 + o); const u32x4 bq = *(const u32x4*)(r2 + o);
            float x1[10], x2[10];
            x1[0] = t0 > 0 ? bf2f(r1[o - 1]) : 0.f; x2[0] = t0 > 0 ? bf2f(r2[o - 1]) : 0.f;
            x1[9] = t0 + 8 < L ? bf2f(r1[o + 8]) : 0.f; x2[9] = t0 + 8 < L ? bf2f(r2[o + 8]) : 0.f;
#pragma unroll
            for (int j = 0; j < 4; ++j) { x1[1 + 2 * j] = bf2f(a[j] & 0xffffu); x1[2 + 2 * j] = bf2f(a[j] >> 16); x2[1 + 2 * j] = bf2f(bq[j] & 0xffffu); x2[2 + 2 * j] = bf2f(bq[j] >> 16); }
            float z[8];
#pragma unroll
            for (int j = 0; j < 8; ++j) z[j] = (b1 + w10 * x1[j] + w11 * x1[j + 1] + w12 * x1[j + 2]) * (b2 + w20 * x2[j] + w21 * x2[j + 1] + w22 * x2[j + 2]);
            u32x4 w; w.x = pack2(z[0], z[1]); w.y = pack2(z[2], z[3]); w.z = pack2(z[4], z[5]); w.w = pack2(z[6], z[7]);
            *(LAS u32x4*)(lds + Z_OFF + ((t0 >> 6) * 8 + b) * ZSTRIDE + (t0 & 63) * 2) = w;
        }
    }
    __syncthreads();
    {
        const LAS unsigned* D = (const LAS unsigned*)lds;
        for (int v = tid; v < FLEN / 8; v += 512) {
            unsigned d[8];
#pragma unroll
            for (int i = 0; i < 8; ++i) d[i] = D[4 * v + i];
#pragma unroll
            for (int j = 1; j < 8; ++j) {
                u32x4 w;
#pragma unroll
                for (int i = 0; i < 4; ++i) w[i] = (j & 1) ? __builtin_amdgcn_alignbyte(d[i + (j + 1) / 2], d[i + (j - 1) / 2], 2) : d[i + j / 2];
                *(LAS u32x4*)(lds + j * CSTRIDE + v * 16) = w;
            }
        }
    }
    __syncthreads();
    const int mb0 = (L == SEQ) ? 0 : (wid & 3), cb0 = (L == SEQ) ? 2 * wid : (wid >> 2);
    f32x4 acc[CBW][MB];
#pragma unroll
    for (int x = 0; x < CBW; ++x)
#pragma unroll
        for (int m = 0; m < MB; ++m) acc[x][m] = (f32x4){0.f, 0.f, 0.f, 0.f};
    const int jj = (7 - fr) & 7;
    const int abase = jj * CSTRIDE + 2 * ((L - 1) - fr - jj + 8 * fq);
    const int ilo = 2 * cb0, ihi = 2 * (cb0 + CBW) - 1;
    if constexpr (L == SEQ) {
        const int col = 16 * cb0 + fr, ib = col >> 3;
        auto getB = [&](int dd, bf16x8 (&o)[2]) {
            const int ip = ib - dd; const bool ok = (ip >= 0) && (ip < NBLK); const int colp = ok ? col - 8 * dd : col;
#pragma unroll
            for (int k = 0; k < 2; ++k) { bf16x8 v = *(const LAS bf16x8*)(lds + Z_OFF + colp * ZSTRIDE + (32 * k + 8 * fq) * 2); if (!ok) v = (bf16x8){0, 0, 0, 0, 0, 0, 0, 0}; o[k] = v; }
        };
        const int d0 = ilo - (NBLK - 1);
        bf16x8 F[6], h0[2], h1[2], bn[2];
        getB(d0 - 2, h0); getB(d0 - 1, h1);
        F[4] = *(const LAS bf16x8*)(lds + abase - 32 * (4 * d0 - 2)); F[5] = *(const LAS bf16x8*)(lds + abase - 32 * (4 * d0 - 1));
#pragma unroll 2
        for (int d = d0; d <= ihi; ++d) {
            F[0] = F[4]; F[1] = F[5];
#pragma unroll
            for (int i = 2; i < 6; ++i) F[i] = *(const LAS bf16x8*)(lds + abase - 32 * (4 * d - 2 + i));
            getB(d, bn);
#pragma unroll
            for (int m = 0; m < 4; ++m) {
                acc[0][m] = __builtin_amdgcn_mfma_f32_16x16x32_bf16(F[m + 2], bn[0], acc[0][m], 0, 0, 0);
                acc[0][m] = __builtin_amdgcn_mfma_f32_16x16x32_bf16(F[m], bn[1], acc[0][m], 0, 0, 0);
                acc[1][m] = __builtin_amdgcn_mfma_f32_16x16x32_bf16(F[m + 2], h0[0], acc[1][m], 0, 0, 0);
                acc[1][m] = __builtin_amdgcn_mfma_f32_16x16x32_bf16(F[m], h0[1], acc[1][m], 0, 0, 0);
            }
            h0[0] = h1[0]; h0[1] = h1[1]; h1[0] = bn[0]; h1[1] = bn[1];
        }
    } else {
    for (int d = ilo - (NBLK - 1); d <= ihi; ++d) {
        bf16x8 af[MB][2];
#pragma unroll
        for (int m = 0; m < MB; ++m)
#pragma unroll
            for (int k = 0; k < 2; ++k) af[m][k] = *(const LAS bf16x8*)(lds + abase + 2 * (-64 * d - 16 * (mb0 + m) + 32 * k));
#pragma unroll
        for (int x = 0; x < CBW; ++x) {
            const int col = 16 * (cb0 + x) + fr, ip = (col >> 3) - d;
            const bool ok = (ip >= 0) && (ip < NBLK);
            const int colp = ok ? col - 8 * d : col;
            bf16x8 bfr[2];
#pragma unroll
            for (int k = 0; k < 2; ++k) {
                bf16x8 v = *(const LAS bf16x8*)(lds + Z_OFF + colp * ZSTRIDE + (32 * k + 8 * fq) * 2);
                if (!ok) v = (bf16x8){0, 0, 0, 0, 0, 0, 0, 0};
                bfr[k] = v;
            }
#pragma unroll
            for (int m = 0; m < MB; ++m)
#pragma unroll
                for (int k = 0; k < 2; ++k) acc[x][m] = __builtin_amdgcn_mfma_f32_16x16x32_bf16(af[m][k], bfr[k], acc[x][m], 0, 0, 0);
        }
    }
    }
    {
        const float w00 = cw[0 * 3072 + c], w01 = cw[1 * 3072 + c], w02 = cw[2 * 3072 + c], b0 = cb[c], fbias = p.in[22][c];
        const bf16_t* r0 = UT + (size_t)c * T_ALL + tok0;
#pragma unroll
        for (int x = 0; x < CBW; ++x)
#pragma unroll
            for (int m = 0; m < MB; ++m) {
                const int col = 16 * (cb0 + x) + fr, i = col >> 3, b = col & 7, r = 16 * (mb0 + m) + 4 * fq, t = 64 * i + r;
                const size_t o = (size_t)b * L + t;
                const u32x2 xr = *(const u32x2*)(r0 + o);
                float xv[6];
                xv[0] = t > 0 ? bf2f(r0[o - 1]) : 0.f; xv[5] = t + 4 < L ? bf2f(r0[o + 4]) : 0.f;
                xv[1] = bf2f(xr.x & 0xffffu); xv[2] = bf2f(xr.x >> 16); xv[3] = bf2f(xr.y & 0xffffu); xv[4] = bf2f(xr.y >> 16);
                const u32x2 zr = *(const LAS u32x2*)(lds + Z_OFF + col * ZSTRIDE + r * 2);
                const float zv[4] = {bf2f(zr.x & 0xffffu), bf2f(zr.x >> 16), bf2f(zr.y & 0xffffu), bf2f(zr.y >> 16)};
                float o4[4];
#pragma unroll
                for (int j = 0; j < 4; ++j) o4[j] = (b0 + w00 * xv[j] + w01 * xv[j + 1] + w02 * xv[j + 2]) * (acc[x][m][j] + fbias * zv[j]);
                u32x2 w; w.x = pack2(o4[0], o4[1]); w.y = pack2(o4[2], o4[3]);
                *(u32x2*)(YT + (size_t)c * T_ALL + tok0 + o) = w;
            }
    }
    __syncthreads();
}
__device__ __forceinline__ void longconv_phase(PARG p, LAS unsigned char* lds) {
    for (int c = blockIdx.x; c < DM; c += gridDim.x) longconv_channel<SEQ>(p, lds, c);
    for (int c = blockIdx.x; c < DM; c += gridDim.x) longconv_channel<CTXL>(p, lds, c);
}

__device__ __forceinline__ void transpose_phase(PARG p, LAS unsigned char* lds) {
    const bf16_t* S = (const bf16_t*)(p.ws + OFF_Y); bf16_t* Dst = (bf16_t*)(p.out);
    LAS bf16_t* t = (LAS bf16_t*)lds;
    const int tid = threadIdx.x;
    const int nitem = 16 * (T_ALL / 64);
    const int lc = tid >> 3, lt8 = (tid & 7) * 8;
    u32x4 cur = (u32x4){0u, 0u, 0u, 0u};
    if ((int)blockIdx.x < nitem) { const int c0 = (blockIdx.x & 15) * 64, t0 = (blockIdx.x >> 4) * 64; cur = *(const u32x4*)(S + (size_t)(c0 + lc) * T_ALL + t0 + lt8); }
    for (int item = blockIdx.x; item < nitem; item += gridDim.x) {
        const int c0 = (item & 15) * 64, t0 = (item >> 4) * 64;
        const int nx = item + gridDim.x;
        u32x4 nxt = cur;
        if (nx < nitem) { const int c1 = (nx & 15) * 64, t1 = (nx >> 4) * 64; nxt = *(const u32x4*)(S + (size_t)(c1 + lc) * T_ALL + t1 + lt8); }
        *(LAS u32x4*)(t + lc * 72 + lt8) = cur;
        __syncthreads();
        { const int tt = tid >> 3, c8 = (tid & 7) * 8;
          unsigned v[8];
#pragma unroll
          for (int j = 0; j < 8; ++j) v[j] = t[(c8 + j) * 72 + tt];
          u32x4 w; w.x = v[0] | (v[1] << 16); w.y = v[2] | (v[3] << 16); w.z = v[4] | (v[5] << 16); w.w = v[6] | (v[7] << 16);
          *(u32x4*)(Dst + (size_t)(t0 + tt) * DM + c0 + c8) = w; }
        __syncthreads();
        cur = nxt;
    }
}

__device__ __forceinline__ void rgconv_phase(PARG p) {
    const bf16_t* R = (const bf16_t*)(p.ws + OFF_BIG + 37748736); bf16_t* XC = (bf16_t*)(p.out);
    const float* cw = p.in[27]; const float* cb = p.in[28];
#pragma unroll 2
    for (int it = blockIdx.x * 512 + threadIdx.x; it < T_ALL * 128; it += gridDim.x * 512) {
        const int row = it >> 7, c8 = (it & 127) * 8;
        int t, L;
        if (row < T_LAT) { t = row & (SEQ - 1); L = SEQ; } else { t = (row - T_LAT) & (CTXL - 1); L = CTXL; }
        float o[8];
#pragma unroll
        for (int j = 0; j < 8; ++j) o[j] = cb[c8 + j];
        u32x4 rv[4];
#pragma unroll
        for (int k = 0; k < 4; ++k) {
            const int tt = t + k - 1; const bool ok = (tt >= 0) && (tt < L);
            rv[k] = *(const u32x4*)(R + (size_t)(ok ? row + k - 1 : row) * DM + c8);
            if (!ok) rv[k] = (u32x4){0u, 0u, 0u, 0u};
        }
#pragma unroll
        for (int k = 0; k < 4; ++k) {
            const u32x4 v = rv[k];
            const f32x4 w0 = *(const f32x4*)(cw + k * DM + c8), w1 = *(const f32x4*)(cw + k * DM + c8 + 4);
#pragma unroll
            for (int j = 0; j < 4; ++j) { const float lo = bf2f(v[j] & 0xffffu), hi = bf2f(v[j] >> 16);
                o[2 * j] += lo * (j < 2 ? w0[2 * j] : w1[2 * j - 4]); o[2 * j + 1] += hi * (j < 2 ? w0[2 * j + 1] : w1[2 * j - 3]); }
        }
        u32x4 w; w.x = pack2(o[0], o[1]); w.y = pack2(o[2], o[3]); w.z = pack2(o[4], o[5]); w.w = pack2(o[6], o[7]);
        *(u32x4*)(XC + (size_t)row * DM + c8) = w;
    }
}

__device__ __forceinline__ int scan_row(int dir, int b, int q) {
    if (q < CTXL) return T_LAT + b * CTXL + (dir ? (CTXL - 1 - q) : q);
    const int t = q - CTXL; return b * SEQ + (dir ? (SEQ - 1 - t) : t);
}
__device__ __forceinline__ void scan_agg_phase(PARG p) {
    const unsigned* GA0 = (const unsigned*)(p.ws + OFF_BIG + 37748736); const unsigned* GA1 = (const unsigned*)(p.ws + OFF_EXTRA);
    f32x2* AGG = (f32x2*)(p.ws + OFF_Y);
    const int lane = threadIdx.x & 63, wv = threadIdx.x >> 6;
    for (int item = blockIdx.x * 8 + wv; item < 2 * 8 * 36 * 16; item += gridDim.x * 8) {
        const int cg_ = item & 15, k = (item >> 4) % 36, b = ((item >> 4) / 36) & 7, dir = (item >> 4) / 288;
        const int ch = cg_ * 64 + lane;
        const unsigned* GA = dir ? GA1 : GA0;
        const int r0 = scan_row(dir, b, 64 * k); const int step = dir ? -1 : 1;
        float A = 1.f, Bv = 0.f;
#pragma unroll 16
        for (int s = 0; s < 64; ++s) {
            const unsigned v = GA[(size_t)(r0 + step * s) * DM + ch];
            const float a = __expf(bf2f(v & 0xffffu)), bb = bf2f(v >> 16);
            A *= a; Bv = a * Bv + bb;
        }
        AGG[(((size_t)dir * 8 + b) * 36 + k) * DM + ch] = (f32x2){A, Bv};
    }
}
__device__ __forceinline__ void scan_out_phase(PARG p) {
    const unsigned* GA0 = (const unsigned*)(p.ws + OFF_BIG + 37748736); const unsigned* GA1 = (const unsigned*)(p.ws + OFF_EXTRA);
    const f32x2* AGG = (const f32x2*)(p.ws + OFF_Y);
    const bf16_t* G = (const bf16_t*)(p.ws + OFF_BIG);
    bf16_t* H = (bf16_t*)(p.out);
    const int lane = threadIdx.x & 63, wv = threadIdx.x >> 6;
    for (int item = blockIdx.x * 8 + wv; item < 8 * 32 * 16; item += gridDim.x * 8) {
        const int cg_ = item & 15, kl = (item >> 4) & 31, b = item >> 9;
        const int ch = cg_ * 64 + lane;
        float hf = 0.f, hr = 0.f;
        {
            const f32x2* ag0 = AGG + ((size_t)0 * 8 + b) * 36 * DM + ch; const int n0 = 4 + kl;
            const f32x2* ag1 = AGG + ((size_t)1 * 8 + b) * 36 * DM + ch; const int n1 = 4 + (31 - kl);
#pragma unroll 1
            for (int k0 = 0; k0 < 36; k0 += 12) {
                f32x2 v0[12], v1[12];
#pragma unroll
                for (int k = 0; k < 12; ++k) { v0[k] = (k0 + k < n0) ? ag0[(size_t)(k0 + k) * DM] : (f32x2){1.f, 0.f}; v1[k] = (k0 + k < n1) ? ag1[(size_t)(k0 + k) * DM] : (f32x2){1.f, 0.f}; }
#pragma unroll
                for (int k = 0; k < 12; ++k) { hf = v0[k].x * hf + v0[k].y; hr = v1[k].x * hr + v1[k].y; }
            }
            asm volatile("" ::: "memory");
        }
        const int row0 = b * SEQ + kl * 64;
        float hs[64];
#pragma unroll
        for (int s = 0; s < 64; ++s) {
            const unsigned v = GA0[(size_t)(row0 + s) * DM + ch];
            hf = __expf(bf2f(v & 0xffffu)) * hf + bf2f(v >> 16); hs[s] = hf;
        }
#pragma unroll
        for (int s = 63; s >= 0; --s) {
            const unsigned v = GA1[(size_t)(row0 + s) * DM + ch];
            hr = __expf(bf2f(v & 0xffffu)) * hr + bf2f(v >> 16);
            const float g = bf2f(G[(size_t)(row0 + s) * DM + ch]);
            H[(size_t)(row0 + s) * DM + ch] = (bf16_t)(cvt_pk_bf16((hs[s] + hr) * geluf_(g), 0.f) & 0xffffu);
        }
    }
}


#define XB_TMO      128
#define XB_XCNT(j)  (256  + 64 * (j))
#define XB_XSUB(j)  (1280 + 64 * (j))
#define XB_XGEN(j)  (2304 + 64 * (j))
#define XB_TOP      3328
#define XB_TOPGEN   3392
#define XCD_BAR_WORDS 3456
#define XB_SPIN_CAP (1u << 18)
__device__ __forceinline__ unsigned xb_ld(unsigned* p)              { return __hip_atomic_load(p, __ATOMIC_RELAXED, __HIP_MEMORY_SCOPE_AGENT); }
__device__ __forceinline__ unsigned xb_add(unsigned* p, unsigned v) { return __hip_atomic_fetch_add(p, v, __ATOMIC_RELAXED, __HIP_MEMORY_SCOPE_AGENT); }
__device__ __forceinline__ unsigned xb_xcc_id() { return (unsigned)__builtin_amdgcn_s_getreg((3 << 11) | 20) & 0xFu; }
#define XB_SPIN(cond, bar) do { unsigned _sp = 0; while (cond) { __builtin_amdgcn_s_sleep(1); \
    if ((++_sp & 255u) == 0u) { if (xb_ld(&(bar)[XB_TMO])) break; if (_sp > XB_SPIN_CAP) { atomicAdd(&(bar)[XB_TMO], 1u); break; } } } } while (0)
struct XcdBarrier { unsigned* bar; unsigned x; volatile LAS unsigned* st; };
__device__ __forceinline__ XcdBarrier xcd_barrier_post(unsigned* bar, volatile LAS unsigned* st) {
    XcdBarrier b; b.bar = bar; b.x = xb_xcc_id(); b.st = st;
    if (threadIdx.x == 0) (void)xb_add(&bar[XB_XCNT(b.x)], 1u);
    return b;
}
__device__ __forceinline__ void xcd_barrier_complete(unsigned* bar, unsigned x, unsigned& nloc, unsigned& nx) {
    const unsigned G = gridDim.x * gridDim.y * gridDim.z;
    unsigned sum, cnt, mine, sp = 0u;
    for (;;) {
        sum = 0u; cnt = 0u; mine = 0u;
#pragma unroll
        for (unsigned j = 0; j < 16; ++j) { const unsigned c = xb_ld(&bar[XB_XCNT(j)]); sum += c; cnt += (c > 0u) ? 1u : 0u; mine = (j == x) ? c : mine; }
        if (sum == G) break;
        __builtin_amdgcn_s_sleep(1);
        if ((++sp & 255u) == 0u) { if (xb_ld(&bar[XB_TMO])) break; if (sp > XB_SPIN_CAP) { atomicAdd(&bar[XB_TMO], 1u); break; } }
    }
    nloc = mine > 0u ? mine : 1u; nx = cnt > 0u ? cnt : 1u;
}
__device__ __forceinline__ void xcd_barrier(const XcdBarrier& b) {
    asm volatile("s_waitcnt vmcnt(0)" ::: "memory");
    __syncthreads();
    if (threadIdx.x == 0) {
        unsigned* bar = b.bar;
        __builtin_amdgcn_s_waitcnt(0);
        unsigned nloc = b.st[0], nx = b.st[1];
        if (nloc == 0u) { xcd_barrier_complete(bar, b.x, nloc, nx); b.st[0] = nloc; b.st[1] = nx; }
        const unsigned old = xb_add(&bar[XB_XSUB(b.x)], 1u);
        const unsigned gen = old / nloc;
        if (old + 1u == (gen + 1u) * nloc) {
            __builtin_amdgcn_fence(__ATOMIC_RELEASE, "agent");
            asm volatile("s_waitcnt vmcnt(0)" ::: "memory");
            const unsigned og = xb_add(&bar[XB_TOP], 1u);
            const unsigned tg = og / nx;
            if (og + 1u == (tg + 1u) * nx) xb_add(&bar[XB_TOPGEN], 1u);
            else XB_SPIN(xb_ld(&bar[XB_TOPGEN]) == tg, bar);
            __builtin_amdgcn_fence(__ATOMIC_ACQUIRE, "agent");
            xb_add(&bar[XB_XGEN(b.x)], 1u);
            asm volatile("s_waitcnt vmcnt(0)" ::: "memory");
        } else {
            XB_SPIN(xb_ld(&bar[XB_XGEN(b.x)]) == gen, bar);
            __builtin_amdgcn_fence(__ATOMIC_ACQUIRE, "agent");
            asm volatile("s_waitcnt vmcnt(0)" ::: "memory");
        }
    }
    __syncthreads();
}

__device__ __forceinline__ void run_gemm1(PARG p, LAS unsigned char* lds, int s, int M) {
    const bf16_t* W = (const bf16_t*)(p.ws + OFF_W);
    pg8::Gemm g{(const bf16_t*)(p.out), W + (s ? W_13_1 : W_13_0), M, 2 * FF, DM, DM, DM, 1 << 20, 0};
    pg8::StaticOrder S; S.init(T_LAT, g.N, g.K, gridDim.x, blockIdx.x, (M - T_LAT) / 256, 1);
    pg8::EpiSwiglu E{(bf16_t*)(p.ws + OFF_BIG)};
    pg8::gemm_phase(lds, g, S, E);
}
__device__ __forceinline__ void run_gemm2(PARG p, LAS unsigned char* lds, int s, int M) {
    const bf16_t* W = (const bf16_t*)(p.ws + OFF_W);
    pg8::Gemm g{(const bf16_t*)(p.ws + OFF_BIG), W + (s ? W_2_1 : W_2_0), M, DM, FF, FF, FF, 1 << 20, 0};
    pg8::StaticOrder S; S.init(T_LAT, g.N, g.K, gridDim.x, blockIdx.x, (M - T_LAT) / 256, 2);
    pg8::EpiBf16 E{(bf16_t*)(p.ws + OFF_Y), DM, nullptr, nullptr, 0, 0, (bf16_t*)(p.ws + OFF_YP)};
    pg8::gemm_phase(lds, g, S, E);
}

#ifndef PHSEL
#define PHSEL -1
#endif
__device__ __forceinline__ void run_phase(PARG p, LAS unsigned char* lds, int ph) {
    const bf16_t* W = (const bf16_t*)(p.ws + OFF_W);
    switch (ph) {
    case 0: if (PHSEL >= 0 && PHSEL != 0) break; ada_phase(p, lds); filter_phase(p, lds); convert_weights(p, lds, 0, 0, 0); break;
    case 1: if (PHSEL >= 0 && PHSEL != 1) break; ew_phase(p, EwArgs{1, 1, T_ALL, 0.f, 0, 0, 0, 0, 0, 0, 1, 1}); break;
    case 2: if (PHSEL >= 0 && PHSEL != 2) break; run_gemm1(p, lds, 0, T_ALL); convert_weights(p, lds, 0, 1, 48); break;
    case 3: if (PHSEL >= 0 && PHSEL != 3) break; run_gemm2(p, lds, 0, T_ALL); break;
    case 4: if (PHSEL >= 0 && PHSEL != 4) break; ew_phase(p, EwArgs{0, 1, T_ALL, 0.5f, 0, 2, 1, 0, 2, 3, 4, 2}); break;
    case 5: if (PHSEL >= 0 && PHSEL != 5) break; {
        pg8::Gemm g{W + W_HYIN, (const bf16_t*)(p.out), 3 * DM, T_ALL, DM, DM, DM, 1 << 20, 0};
        pg8::StaticOrder S; S.init(g.M, g.N, g.K, gridDim.x, blockIdx.x, 0, 1);
        pg8::EpiBf16 E{(bf16_t*)(p.ws + OFF_BIG), T_ALL, nullptr, p.in[11], 0, 0, nullptr};
        pg8::gemm_phase(lds, g, S, E);
    } break;
    case 6: if (PHSEL >= 0 && PHSEL != 6) break; longconv_phase(p, lds); break;
    case 7: if (PHSEL >= 0 && PHSEL != 7) break; transpose_phase(p, lds); break;
    case 8: if (PHSEL >= 0 && PHSEL != 8) break; {
        pg8::Gemm g{(const bf16_t*)(p.out), W + W_HYOUT, T_ALL, DM, DM, DM, DM, 1 << 20, 0};
        pg8::StaticOrder S; S.init(T_LAT, g.N, g.K, gridDim.x, blockIdx.x, 8, 4);
        pg8::EpiBf16 E{(bf16_t*)(p.ws + OFF_Y), DM, p.in[24], nullptr, 0, 0, (bf16_t*)(p.ws + OFF_YP)};
        pg8::gemm_phase(lds, g, S, E);
    } break;
    case 9: if (PHSEL >= 0 && PHSEL != 9) break; ew_phase(p, EwArgs{0, 1, T_ALL, 1.0f, 0, 5, 3, 0, 4, 6, 7, 4}); break;
    case 10: if (PHSEL >= 0 && PHSEL != 10) break; run_gemm1(p, lds, 1, T_ALL); break;
    case 11: if (PHSEL >= 0 && PHSEL != 11) break; run_gemm2(p, lds, 1, T_ALL); break;
    case 12: if (PHSEL >= 0 && PHSEL != 12) break; ew_phase(p, EwArgs{0, 1, T_ALL, 0.5f, 0, 8, 5, 1, 0, 0, 1, 2}); convert_weights(p, lds, 1, 0, 0);
        if (blockIdx.x == gridDim.x - 1) for (int i = threadIdx.x; i < 2 * DM; i += 512) ((float*)(p.ws + OFF_SP8))[i] = -8.0f * log1pf(__expf(-p.in[33][i]));
        break;
    case 13: if (PHSEL >= 0 && PHSEL != 13) break; run_gemm1(p, lds, 0, T_ALL); convert_weights(p, lds, 1, 1, 48); break;
    case 14: if (PHSEL >= 0 && PHSEL != 14) break; run_gemm2(p, lds, 0, T_ALL); break;
    case 15: if (PHSEL >= 0 && PHSEL != 15) break; ew_phase(p, EwArgs{0, 1, T_ALL, 0.5f, 1, 2, 1, 1, 2, 3, 4, 2}); break;
    case 16: if (PHSEL >= 0 && PHSEL != 16) break; {
        pg8::Gemm g{(const bf16_t*)(p.out), W + W_RGIN, T_ALL, 2 * DM, DM, DM, DM, 1 << 20, 0};
        pg8::StaticOrder S; S.init(T_LAT, g.N, g.K, gridDim.x, blockIdx.x, 8, 1);
        pg8::EpiBf16 E{(bf16_t*)(p.ws + OFF_BIG), DM, p.in[26], nullptr, DM, (size_t)T_ALL * DM, nullptr};
        pg8::gemm_phase(lds, g, S, E);
    } break;
    case 17: if (PHSEL >= 0 && PHSEL != 17) break; rgconv_phase(p); break;
    case 18: if (PHSEL >= 0 && PHSEL != 18) break; {
        pg8::Gemm g{(const bf16_t*)(p.out), W + W_GATE, T_ALL, 4096, 256, DM, 256, 4, 256};
        pg8::StaticOrder S; S.init(T_LAT, g.N, g.K, gridDim.x, blockIdx.x, 8, 1);
        pg8::EpiGate E{(unsigned*)(p.ws + OFF_BIG + 37748736), (unsigned*)(p.ws + OFF_EXTRA), (const bf16_t*)(p.out), p.in[30], p.in[32], (const float*)(p.ws + OFF_SP8), (f32x2*)(p.ws + OFF_Y)};
        pg8::gemm_phase(lds, g, S, E);
    } break;
    case 19: break;
    case 20: if (PHSEL >= 0 && PHSEL != 20) break; scan_out_phase(p); break;
    case 21: if (PHSEL >= 0 && PHSEL != 21) break; {
        pg8::Gemm g{(const bf16_t*)(p.out), W + W_RGOUT, T_LAT, DM, DM, DM, DM, 1 << 20, 0};
        pg8::StaticOrder S; S.init(T_LAT, g.N, g.K, gridDim.x, blockIdx.x, 0, 1);
        pg8::EpiBf16 E{(bf16_t*)(p.ws + OFF_Y), DM, p.in[35], nullptr, 0, 0, nullptr};
        pg8::gemm_phase(lds, g, S, E);
    } break;
    case 22: if (PHSEL >= 0 && PHSEL != 22) break; ew_phase(p, EwArgs{0, 1, T_LAT, 1.0f, 1, 5, 3, 1, 4, 6, 7, 1}); break;
    case 23: if (PHSEL >= 0 && PHSEL != 23) break; run_gemm1(p, lds, 1, T_LAT); break;
    case 24: if (PHSEL >= 0 && PHSEL != 24) break; run_gemm2(p, lds, 1, T_LAT); break;
    case 25: if (PHSEL >= 0 && PHSEL != 25) break; ew_phase(p, EwArgs{0, 0, T_LAT, 0.5f, 1, 8, 5, 0, 0, 0, 0, 1}); break;
    default: break;
    }
}

__global__ void __launch_bounds__(512, 2) mega_kernel(Params p) {
    extern __shared__ __attribute__((aligned(16))) unsigned char shm[];
    LAS unsigned char* lds = (LAS unsigned char*)shm;
    cg::grid_group grid = cg::this_grid();
    typedef const __attribute__((address_space(4))) Params* KP;
    const KP kp = (KP)__builtin_amdgcn_kernarg_segment_ptr();
    volatile LAS unsigned* st = (volatile LAS unsigned*)(lds + LDS_MAIN);
    if (threadIdx.x == 0) { st[0] = 0u; st[1] = 0u; }
    __syncthreads();
    XcdBarrier xb; xb.bar = nullptr; xb.x = 0; xb.st = st;
    if (kp->ph_hi - kp->ph_lo > 1) xb = xcd_barrier_post((unsigned*)(kp->ws + OFF_BAR), st);
    if (kp->ph_hi > 4096) grid.sync();
#define PH(k) { KP q = kp; asm volatile("" : "+s"(q)); const int lo_ = q->ph_lo, hi_ = q->ph_hi; if (lo_ <= (k) && (k) < hi_) { run_phase(*q, lds, (k)); if ((REPEAT_MASK >> (k)) & 1u) { xcd_barrier(xb); run_phase(*q, lds, (k)); } if ((k) + 1 < hi_) xcd_barrier(xb); } }
    PH(0) PH(1) PH(2) PH(3) PH(4) PH(5) PH(6) PH(7) PH(8) PH(9) PH(10) PH(11) PH(12) PH(13) PH(14) PH(15) PH(16) PH(17) PH(18) PH(20) PH(21) PH(22) PH(23) PH(24) PH(25)
#undef PH
}

#ifndef N_LAUNCH_MODE
#define N_LAUNCH_MODE 0
#endif

extern "C" void kernel_launch(void* const* d_in, const int* in_sizes, int n_in, void* d_out, int out_size, void* d_ws, size_t ws_size, hipStream_t stream) {
    static int grid = 0;
    if (grid == 0) {
        if (n_in != 36 || ws_size < WS_END) { fprintf(stderr, "kernel_launch: unexpected n_in %d / ws_size %zu (need %zu)\n", n_in, ws_size, (size_t)WS_END); grid = -1; return; }
        int dev = 0, cus = 0, per_cu = 0;
        hipGetDevice(&dev);
        hipDeviceGetAttribute(&cus, hipDeviceAttributeMultiprocessorCount, dev);
        if (hipFuncSetAttribute((const void*)mega_kernel, hipFuncAttributeMaxDynamicSharedMemorySize, LDS_BYTES) != hipSuccess) { fprintf(stderr, "hipFuncSetAttribute failed\n"); grid = -1; return; }
        if (hipOccupancyMaxActiveBlocksPerMultiprocessor(&per_cu, (const void*)mega_kernel, 512, LDS_BYTES) != hipSuccess || per_cu < 1) { fprintf(stderr, "occupancy query: %d\n", per_cu); per_cu = 1; }
        (void)hipGetLastError();
        grid = cus * 1;
    }
    if (grid < 0) return;
    Params p{};
    for (int i = 0; i < 36; ++i) p.in[i] = (const float*)d_in[i];
    p.out = (float*)d_out; p.ws = (unsigned char*)d_ws;
#if N_LAUNCH_MODE == 1
    for (int ph = 0; ph < NPHASE; ++ph) {
        p.ph_lo = ph; p.ph_hi = ph + 1;
        hipLaunchKernelGGL(mega_kernel, dim3(grid), dim3(512), LDS_BYTES, stream, p);
    }
#else
    p.ph_lo = 0; p.ph_hi = NPHASE;
    if (hipMemsetAsync((unsigned char*)d_ws + OFF_BAR, 0, XCD_BAR_WORDS * 4, stream) != hipSuccess) { fprintf(stderr, "memset failed\n"); return; }
    void* args[] = {&p};
    hipError_t e = hipLaunchCooperativeKernel((const void*)mega_kernel, dim3(grid), dim3(512), args, LDS_BYTES, stream);
    if (e != hipSuccess) fprintf(stderr, "cooperative launch failed: %s (grid %d)\n", hipGetErrorString(e), grid);
#endif
}
```
